# Optimizing an MI355X kernel written in HIP

```python
import jax, jax.numpy as jnp
from jax import lax
import numpy as np

D_MODEL = 2048
BATCH = 8
SEQ = 2048
DEPTH = 1
DEC_BATCH = 128
DEC_SEQ = 1
PAST_LEN = 16384
PAGE_SIZE = 128

HEAD_DIM = 64
D_MIX = D_MODEL
D_RWKV = D_MIX // 2
D_ATTN = D_MIX - D_RWKV
N_RWKV_HEADS = D_RWKV // HEAD_DIM
N_Q_HEADS = D_ATTN // HEAD_DIM
N_KV_HEADS = 4
GROUP = N_Q_HEADS // N_KV_HEADS
WINDOW = 128
BLOCK = WINDOW
LORA_DECAY = 96
LORA_A = 96
LORA_GATE = 256
RWKV_PROJ = 3 * D_RWKV + LORA_DECAY + LORA_A + LORA_GATE
ATTN_PROJ = D_ATTN + 2 * N_KV_HEADS * HEAD_DIM
PROJ = RWKV_PROJ + ATTN_PROJ
D_FF = ((8 * D_MODEL + 3 * 256 - 1) // (3 * 256)) * 256
PLE_DIM = 256
EPS = 1e-6
GN_EPS = 64e-5
SCALE = HEAD_DIM ** -0.5
RWKV_SPLITS = [D_RWKV, 2 * D_RWKV, 3 * D_RWKV, 3 * D_RWKV + LORA_DECAY, 3 * D_RWKV + LORA_DECAY + LORA_A]
ATTN_SPLITS = [D_ATTN, D_ATTN + N_KV_HEADS * HEAD_DIM]

kernel_name = "hymba_rwkv7_swa_sink_alibi_decode_step"


def rms_norm(x, g):
    x32 = x.astype(jnp.float32)
    y = x32 * lax.rsqrt(jnp.mean(x32 * x32, axis=-1, keepdims=True) + EPS)
    return (y * g.astype(jnp.float32)).astype(x.dtype)


def alibi_slopes():
    return 2.0 ** (-8.0 * jnp.arange(1, N_Q_HEADS + 1, dtype=jnp.float32) / N_Q_HEADS)


def rwkv7_time_mix(zr, shift_prev, wkv0, mu, w0, w2, a0, a2, g2, k_k, k_a, r_k, ln_w, ln_b):
    b, t, _ = zr.shape
    z_prev = jnp.concatenate([shift_prev[:, None, :].astype(zr.dtype), zr[:, :-1]], axis=1)
    xs = zr + (z_prev - zr) * mu
    r, k, v, xw, xa, xg = jnp.split(xs, RWKV_SPLITS, axis=-1)
    w = -jax.nn.softplus(-(w0 + jnp.tanh(xw) @ w2)) - 0.5
    a = jax.nn.sigmoid(a0 + xa @ a2)
    g = jax.nn.sigmoid(xg) @ g2
    heads = lambda u: u.reshape(b, t, N_RWKV_HEADS, HEAD_DIM).astype(jnp.float32)
    kk = heads(k * k_k)
    kk = kk * lax.rsqrt(jnp.maximum(jnp.sum(kk * kk, axis=-1, keepdims=True), 1e-24))
    k_h = heads(k * (1 + (a - 1) * k_a))
    r_h, v_h, a_h = heads(r), heads(v), heads(a)
    decay = jnp.exp(-jnp.exp(heads(w)))

    def step(S, inp):
        r_t, d_t, k_t, v_t, kk_t, a_t = inp
        sa = jnp.einsum('bhvk,bhk->bhv', S, -kk_t)
        S = (S * d_t[:, :, None, :]
             + sa[..., None] * (kk_t * a_t)[:, :, None, :]
             + v_t[..., None] * k_t[:, :, None, :])
        return S, jnp.einsum('bhvk,bhk->bhv', S, r_t)

    seq_first = lambda u: jnp.swapaxes(u, 0, 1)
    s_fin, y = lax.scan(step, wkv0.astype(jnp.float32),
                        tuple(seq_first(u) for u in (r_h, decay, k_h, v_h, kk, a_h)))
    y = seq_first(y)
    mean = jnp.mean(y, axis=-1, keepdims=True)
    var = jnp.mean(jnp.square(y - mean), axis=-1, keepdims=True)
    y = ((y - mean) * lax.rsqrt(var + GN_EPS)).reshape(b, t, D_RWKV) * ln_w + ln_b
    bonus = (jnp.sum(r_h * k_h * r_k, axis=-1, keepdims=True) * v_h).reshape(b, t, D_RWKV)
    out = (y + bonus) * g
    return out.astype(zr.dtype), zr[:, -1], s_fin


def sink_softmax(scores, valid, sinks):
    scores = jnp.where(valid, scores, -jnp.inf)
    sink = sinks.astype(jnp.float32)[:, :, None, None]
    m = jnp.maximum(jnp.max(scores, axis=-1, keepdims=True), sink)
    p = jnp.exp(scores - m)
    return p / (jnp.sum(p, axis=-1, keepdims=True) + jnp.exp(sink - m))


def swa_prompt(q, k, v, sinks):
    b, t = q.shape[:2]
    nb = t // BLOCK
    qb = q.reshape(b, nb, BLOCK, N_KV_HEADS, GROUP, HEAD_DIM)

    def band(u):
        up = jnp.concatenate([jnp.zeros_like(u[:, :BLOCK]), u], axis=1)
        up = up.reshape(b, nb + 1, BLOCK, N_KV_HEADS, HEAD_DIM)
        return jnp.concatenate([up[:, :-1], up[:, 1:]], axis=2)

    kb, vb = band(k), band(v)
    s = jnp.einsum('bnqkgd,bnskd->bnkgqs', qb, kb, preferred_element_type=jnp.float32) * SCALE
    dist = jnp.arange(BLOCK)[:, None] + BLOCK - jnp.arange(2 * BLOCK)[None, :]
    key_pos = jnp.arange(nb)[:, None] * BLOCK - BLOCK + jnp.arange(2 * BLOCK)[None, :]
    valid = (dist >= 0) & (dist < WINDOW) & (key_pos >= 0)[:, None, None, None, :]
    s = s - alibi_slopes().reshape(N_KV_HEADS, GROUP, 1, 1) * dist.astype(jnp.float32)
    p = sink_softmax(s, valid, sinks.reshape(N_KV_HEADS, GROUP))
    o = jnp.einsum('bnkgqs,bnskd->bnqkgd', p.astype(vb.dtype), vb)
    return o.reshape(b, t, D_ATTN), k[:, -WINDOW:], v[:, -WINDOW:]


def swa_sample(q, k, v, k_buf, v_buf, sinks):
    b, t = q.shape[:2]
    kc = jnp.concatenate([k_buf.astype(k.dtype), k], axis=1)
    vc = jnp.concatenate([v_buf.astype(v.dtype), v], axis=1)
    qg = q.reshape(b, t, N_KV_HEADS, GROUP, HEAD_DIM)
    s = jnp.einsum('btkgd,bskd->bkgts', qg, kc, preferred_element_type=jnp.float32) * SCALE
    dist = jnp.arange(t)[:, None] + WINDOW - jnp.arange(WINDOW + t)[None, :]
    valid = (dist >= 0) & (dist < WINDOW)
    s = s - alibi_slopes().reshape(N_KV_HEADS, GROUP, 1, 1) * dist.astype(jnp.float32)
    p = sink_softmax(s, valid, sinks.reshape(N_KV_HEADS, GROUP))
    o = jnp.einsum('bkgts,bskd->btkgd', p.astype(vc.dtype), vc)
    return o.reshape(b, t, D_ATTN), kc[:, -WINDOW:], vc[:, -WINDOW:]


def decoder_layer(x, p_emb, shift_prev, wkv0, kv_buf, lp):
    b, t = x.shape[:2]
    h = rms_norm(x, lp['norm_mix'])
    z = h @ lp['w_in']
    zr, za = z[..., :RWKV_PROJ], z[..., RWKV_PROJ:]
    y_r, shift_new, wkv_new = rwkv7_time_mix(
        zr, shift_prev, wkv0, lp['mu_shift'], lp['rwkv_w0'], lp['rwkv_w2'], lp['rwkv_a0'],
        lp['rwkv_a2'], lp['rwkv_g2'], lp['rwkv_k_k'], lp['rwkv_k_a'], lp['rwkv_r_k'],
        lp['rwkv_ln_w'], lp['rwkv_ln_b'])
    q, k, v = jnp.split(za, ATTN_SPLITS, axis=-1)
    q = q.reshape(b, t, N_Q_HEADS, HEAD_DIM)
    k = k.reshape(b, t, N_KV_HEADS, HEAD_DIM)
    v = v.reshape(b, t, N_KV_HEADS, HEAD_DIM)
    if kv_buf is None:
        y_a, k_new, v_new = swa_prompt(q, k, v, lp['attn_sinks'])
    else:
        y_a, k_new, v_new = swa_sample(q, k, v, kv_buf[0], kv_buf[1], lp['attn_sinks'])
    x = x + jnp.concatenate([y_r, y_a], axis=-1) @ lp['w_out']
    hf = rms_norm(x, lp['norm_ffn'])
    x = x + (jax.nn.silu(hf @ lp['w_gate']) * (hf @ lp['w_up'])) @ lp['w_down']
    x = x + jax.nn.sigmoid(rms_norm(x, lp['norm_ple']) @ lp['ple_gate']) * (p_emb @ lp['ple_proj'])
    return x, wkv_new, shift_new, k_new, v_new


def setup_inputs(seed: int = 0) -> dict:
    key = jax.random.key(seed)
    ks = iter(jax.random.split(key, 40))
    nrm = lambda shape, scale: scale * jax.random.normal(next(ks), shape, jnp.float32)
    gain = lambda shape: 1.0 + 0.05 * jax.random.normal(next(ks), shape, jnp.float32)
    unif = lambda shape, lo, hi: jax.random.uniform(next(ks), shape, jnp.float32, lo, hi)
    return {
        'x_prompt': nrm((BATCH, SEQ, D_MODEL), 1.0),
        'x_sample': nrm((DEC_BATCH, DEC_SEQ, D_MODEL), 1.0),
        'state_wkv': nrm((DEPTH, DEC_BATCH, N_RWKV_HEADS, HEAD_DIM, HEAD_DIM), 0.3),
        'state_shift': nrm((DEPTH, DEC_BATCH, RWKV_PROJ), 1.0),
        'cache_k': nrm((DEPTH, DEC_BATCH, WINDOW, N_KV_HEADS, HEAD_DIM), 1.0),
        'cache_v': nrm((DEPTH, DEC_BATCH, WINDOW, N_KV_HEADS, HEAD_DIM), 1.0),
        'p_prompt': nrm((DEPTH, BATCH, SEQ, PLE_DIM), 1.0),
        'p_sample': nrm((DEPTH, DEC_BATCH, DEC_SEQ, PLE_DIM), 1.0),
        'norm_mix': gain((DEPTH, D_MODEL)),
        'w_in': nrm((DEPTH, D_MODEL, PROJ), D_MODEL ** -0.5),
        'mu_shift': unif((DEPTH, RWKV_PROJ), 0.0, 1.0),
        'rwkv_w0': unif((DEPTH, D_RWKV), -5.0, 0.0),
        'rwkv_w2': nrm((DEPTH, LORA_DECAY, D_RWKV), LORA_DECAY ** -0.5),
        'rwkv_a0': nrm((DEPTH, D_RWKV), 0.1),
        'rwkv_a2': nrm((DEPTH, LORA_A, D_RWKV), LORA_A ** -0.5),
        'rwkv_g2': nrm((DEPTH, LORA_GATE, D_RWKV), LORA_GATE ** -0.5),
        'rwkv_k_k': gain((DEPTH, D_RWKV)),
        'rwkv_k_a': gain((DEPTH, D_RWKV)),
        'rwkv_r_k': nrm((DEPTH, N_RWKV_HEADS, HEAD_DIM), 0.1),
        'rwkv_ln_w': gain((DEPTH, D_RWKV)),
        'rwkv_ln_b': nrm((DEPTH, D_RWKV), 0.02),
        'attn_sinks': nrm((DEPTH, N_Q_HEADS), 1.0),
        'w_out': nrm((DEPTH, D_MIX, D_MODEL), D_MIX ** -0.5),
        'norm_ffn': gain((DEPTH, D_MODEL)),
        'w_gate': nrm((DEPTH, D_MODEL, D_FF), D_MODEL ** -0.5),
        'w_up': nrm((DEPTH, D_MODEL, D_FF), D_MODEL ** -0.5),
        'w_down': nrm((DEPTH, D_FF, D_MODEL), D_FF ** -0.5),
        'norm_ple': gain((DEPTH, D_MODEL)),
        'ple_gate': nrm((DEPTH, D_MODEL, D_MODEL), D_MODEL ** -0.5),
        'ple_proj': nrm((DEPTH, PLE_DIM, D_MODEL), PLE_DIM ** -0.5),
        'final_norm': gain((D_MODEL,)),
    }


def reference(x_prompt, x_sample, state_wkv, state_shift, cache_k, cache_v, p_prompt, p_sample,
              norm_mix, w_in, mu_shift, rwkv_w0, rwkv_w2, rwkv_a0, rwkv_a2, rwkv_g2, rwkv_k_k,
              rwkv_k_a, rwkv_r_k, rwkv_ln_w, rwkv_ln_b, attn_sinks, w_out, norm_ffn, w_gate, w_up,
              w_down, norm_ple, ple_gate, ple_proj, final_norm):
    xp, xs = x_prompt, x_sample
    bp = x_prompt.shape[0]
    wkv_p, shift_p, k_p, v_p = [], [], [], []
    wkv_s, shift_s, k_s, v_s = [], [], [], []
    for i in range(DEPTH):
        lp = {
            'norm_mix': norm_mix[i], 'w_in': w_in[i], 'mu_shift': mu_shift[i],
            'rwkv_w0': rwkv_w0[i], 'rwkv_w2': rwkv_w2[i], 'rwkv_a0': rwkv_a0[i],
            'rwkv_a2': rwkv_a2[i], 'rwkv_g2': rwkv_g2[i], 'rwkv_k_k': rwkv_k_k[i],
            'rwkv_k_a': rwkv_k_a[i], 'rwkv_r_k': rwkv_r_k[i], 'rwkv_ln_w': rwkv_ln_w[i],
            'rwkv_ln_b': rwkv_ln_b[i], 'attn_sinks': attn_sinks[i], 'w_out': w_out[i],
            'norm_ffn': norm_ffn[i], 'w_gate': w_gate[i], 'w_up': w_up[i], 'w_down': w_down[i],
            'norm_ple': norm_ple[i], 'ple_gate': ple_gate[i], 'ple_proj': ple_proj[i],
        }
        shift0 = jnp.zeros((bp, RWKV_PROJ), xp.dtype)
        wkv_zero = jnp.zeros((bp, N_RWKV_HEADS, HEAD_DIM, HEAD_DIM), jnp.float32)
        xp, a1, a2, a3, a4 = decoder_layer(xp, p_prompt[i], shift0, wkv_zero, None, lp)
        wkv_p.append(a1); shift_p.append(a2); k_p.append(a3); v_p.append(a4)
        xs, b1, b2, b3, b4 = decoder_layer(xs, p_sample[i], state_shift[i], state_wkv[i],
                                           (cache_k[i], cache_v[i]), lp)
        wkv_s.append(b1); shift_s.append(b2); k_s.append(b3); v_s.append(b4)
    y_prompt = rms_norm(xp, final_norm)
    y_sample = rms_norm(xs, final_norm)
    return (y_prompt, y_sample,
            jnp.stack(wkv_p), jnp.stack(shift_p), jnp.stack(k_p), jnp.stack(v_p),
            jnp.stack(wkv_s), jnp.stack(shift_s), jnp.stack(k_s), jnp.stack(v_s))
```

```cpp
#include <hip/hip_runtime.h>
#include <cstdio>
#include <cstdint>

#define GAS __attribute__((address_space(1)))
#define LAS __attribute__((address_space(3)))
typedef unsigned short bf16_t;
typedef short bf16x8 __attribute__((ext_vector_type(8)));
typedef float f32x4 __attribute__((ext_vector_type(4)));
typedef float f32x2 __attribute__((ext_vector_type(2)));
typedef unsigned u32x4 __attribute__((ext_vector_type(4)));
typedef unsigned u32x2 __attribute__((ext_vector_type(2)));

#ifndef MK_ONE_LAUNCH
#define MK_ONE_LAUNCH 0
#endif

constexpr int DM = 2048, SEQ = 2048, MPROMPT = 16384, NSAMP = 128, MTOK = 16512, MP = 16640;
constexpr int ZP = 5120, PROJ = 5056, RWKV_PROJ = 3520, DFF = 5632, PLE = 256;
constexpr int ZQ = 3520, ZK = 4544, ZV = 4800;
constexpr int ZXW = 3072, ZXA = 3168, ZXG = 3264;
constexpr float EPS = 1e-6f, GN_EPS = 64e-5f;
constexpr size_t O_Y = 0, O_WKVP = 33816576, O_SHP = 34340864, O_KP = 34369024, O_VP = 34631168, O_WKVS = 34893312, O_SHS = 43281920, O_KS = 43732480, O_VS = 47926784;
constexpr size_t MiB = 1u << 20;
constexpr size_t WS_CTL = 0, WS_SS1 = 1 * MiB, WS_SS2 = 1 * MiB + 131072, WS_SS3 = 1 * MiB + 262144, WS_RKR = 2 * MiB;
constexpr size_t WS_WIN = 4 * MiB, WS_WOUT = 24 * MiB, WS_WGU = 32 * MiB, WS_WD = 76 * MiB, WS_WPG = 98 * MiB, WS_WPP = 106 * MiB, WS_WLORA = 107 * MiB;
constexpr size_t WS_HB = 109 * MiB, WS_Z = 174 * MiB, WS_LORA = WS_Z + (size_t)MP * ZP * 2, WS_MIX = 434 * MiB, WS_END = 499 * MiB;
constexpr size_t WS_HID = WS_Z, WS_PB = 360 * MiB;
static_assert(WS_LORA + (size_t)MP * 3072 * 2 <= WS_MIX, "ws map");
static_assert(WS_HID + (size_t)MP * DFF * 2 <= WS_PB && WS_PB + (size_t)MP * PLE * 2 <= WS_MIX, "ws map 2");
constexpr int LDS_BYTES = 147456;
constexpr int NPHASE = 11;

__device__ __forceinline__ unsigned f2bf(float f) { unsigned u = __float_as_uint(f); return (u + 0x7fffu + ((u >> 16) & 1u)) >> 16; }
__device__ __forceinline__ unsigned pk2(float lo, float hi) { return f2bf(lo) | (f2bf(hi) << 16); }
__device__ __forceinline__ float bf2f(unsigned b) { return __uint_as_float(b << 16); }
__device__ __forceinline__ float bflo(unsigned w) { return __uint_as_float(w << 16); }
__device__ __forceinline__ float bfhi(unsigned w) { return __uint_as_float(w & 0xffff0000u); }
__device__ __forceinline__ unsigned cvt_pk_bf16(float lo, float hi) { unsigned r; asm volatile("v_cvt_pk_bf16_f32 %0, %1, %2" : "=v"(r) : "v"(lo), "v"(hi)); return r; }
template <int CTRL> __device__ __forceinline__ float dpp_f(float x) { return __int_as_float(__builtin_amdgcn_update_dpp(0, __float_as_int(x), CTRL, 0xf, 0xf, true)); }
__device__ __forceinline__ float row16_sum(float x) { x += dpp_f<0xB1>(x); x += dpp_f<0x4E>(x); x += dpp_f<0x124>(x); x += dpp_f<0x128>(x); return x; }
__device__ __forceinline__ float row16_max(float x) { x = fmaxf(x, dpp_f<0xB1>(x)); x = fmaxf(x, dpp_f<0x4E>(x)); x = fmaxf(x, dpp_f<0x124>(x)); x = fmaxf(x, dpp_f<0x128>(x)); return x; }
__device__ __forceinline__ float wave_sum(float v) { v = row16_sum(v); v += __shfl_xor(v, 16); v += __shfl_xor(v, 32); return v; }
__device__ __forceinline__ float wave_max(float v) { v = row16_max(v); v = fmaxf(v, __shfl_xor(v, 16)); v = fmaxf(v, __shfl_xor(v, 32)); return v; }
__device__ __forceinline__ float sigmoidf_(float x) { return __builtin_amdgcn_rcpf(1.f + __expf(-x)); }
#define LDS_WAIT() asm volatile("s_waitcnt lgkmcnt(0)" ::: "memory")

namespace pg8 {
constexpr int BM = 256, BK = 64, HALF = 128, HTB = HALF * BK * 2, STAGE_BYTES = 8 * HTB, NXCD = 8, WGM = 8;
__host__ __device__ __forceinline__ int lds_byte(int r, int c) { const int st = (r >> 4) * 2 + (c >> 5), rr = r & 15, cc = c & 31, ob = rr * 64 + cc * 2; return st * 1024 + (ob ^ (((ob >> 9) & 1) << 5)); }
__host__ __device__ __forceinline__ void stage_rc(int b, int& R, int& C) { const int st = b / 1024, sb = b % 1024, swz = sb ^ (((sb >> 9) & 1) << 5); R = (st >> 1) * 16 + swz / 64; C = (st & 1) * 32 + (swz % 64) / 2; }
__host__ __device__ __forceinline__ int perm32(int rho) { const int n = rho >> 4, i = rho & 15; return 8 * (i >> 2) + 4 * n + (i & 3); }
struct Unit { int pm, pn; };
struct Gemm { const bf16_t* A; const bf16_t* Bt; int M, N, K, lda, ldb, akdiv, akmul; };
struct StaticOrder {
    int nM, nN, nwg, G, c;
    __host__ __device__ void init(int M, int N, int G_, int c_) { nM = M / BM; nN = N / BM; nwg = nM * nN; G = G_; c = c_; }
    __host__ __device__ bool next(int i, Unit& u) const {
        const long L = (long)i * G + c; if (L >= nwg) return false;
        int wgid = (int)L; { const int q = nwg / NXCD, r = nwg % NXCD, xcd = wgid % NXCD, off = wgid / NXCD; wgid = (xcd < r ? xcd * (q + 1) : r * (q + 1) + (xcd - r) * q) + off; }
        const int nig = WGM * nN, gid = wgid / nig, fm = gid * WGM, gsz = (nM - fm) < WGM ? (nM - fm) : WGM;
        u.pm = fm + ((wgid % nig) % gsz); u.pn = (wgid % nig) / gsz; return true;
    }
};
struct EpiBf16 {
    bf16_t* O; int ldc;
    __device__ __forceinline__ void operator()(const f32x4 (&acc)[2][2][4][2], const Unit& u, int wr, int wc, int fr, int fq) const {
        const int row0 = u.pm * BM + wr * 64 + fr, col0 = u.pn * BM + wc * 32 + 8 * fq;
#pragma unroll
        for (int ai = 0; ai < 2; ++ai)
#pragma unroll
            for (int m = 0; m < 4; ++m) { bf16_t* rowp = O + (size_t)(row0 + ai * HALF + m * 16) * ldc + col0;
#pragma unroll
                for (int bj = 0; bj < 2; ++bj) { const f32x4 v0 = acc[ai][bj][m][0], v1 = acc[ai][bj][m][1];
                    u32x4 w; w.x = cvt_pk_bf16(v0[0], v0[1]); w.y = cvt_pk_bf16(v0[2], v0[3]); w.z = cvt_pk_bf16(v1[0], v1[1]); w.w = cvt_pk_bf16(v1[2], v1[3]);
                    *(u32x4*)(rowp + bj * HALF) = w; } }
    }
};
struct EpiResid {
    const float* xp; const float* xs; float* out; bf16_t* xb; float* ss;
    __device__ __forceinline__ void operator()(const f32x4 (&acc)[2][2][4][2], const Unit& u, int wr, int wc, int fr, int fq) const {
        const int row0 = u.pm * BM + wr * 64 + fr, col0 = u.pn * BM + wc * 32 + 8 * fq;
#pragma unroll
        for (int ai = 0; ai < 2; ++ai)
#pragma unroll
            for (int m = 0; m < 4; ++m) { const int row = row0 + ai * HALF + m * 16; const bool live = row < MTOK;
                const float* src = (row < MPROMPT ? xp + (size_t)row * DM : xs + (size_t)(row - MPROMPT) * DM) + col0;
                float q = 0.f;
#pragma unroll
                for (int bj = 0; bj < 2; ++bj) { f32x4 o0 = {0.f, 0.f, 0.f, 0.f}, o1 = {0.f, 0.f, 0.f, 0.f};
                    if (live) { o0 = *(const f32x4*)(src + bj * HALF); o1 = *(const f32x4*)(src + bj * HALF + 4); }
                    const f32x4 v0 = acc[ai][bj][m][0] + o0, v1 = acc[ai][bj][m][1] + o1;
                    if (live) { float* op = out + (size_t)row * DM + col0 + bj * HALF; *(f32x4*)op = v0; *(f32x4*)(op + 4) = v1; }
                    q += (v0[0] * v0[0] + v0[1] * v0[1]) + (v0[2] * v0[2] + v0[3] * v0[3]) + (v1[0] * v1[0] + v1[1] * v1[1]) + (v1[2] * v1[2] + v1[3] * v1[3]);
                    u32x4 w; w.x = cvt_pk_bf16(v0[0], v0[1]); w.y = cvt_pk_bf16(v0[2], v0[3]); w.z = cvt_pk_bf16(v1[0], v1[1]); w.w = cvt_pk_bf16(v1[2], v1[3]);
                    *(u32x4*)(xb + (size_t)row * DM + col0 + bj * HALF) = w; }
                q += __shfl_xor(q, 16); q += __shfl_xor(q, 32);
                if (fq == 0 && live) atomicAdd(ss + row, q); }
    }
};
struct EpiGateUp {
    bf16_t* H; const float* ss;
    __device__ __forceinline__ void operator()(const f32x4 (&acc)[2][2][4][2], const Unit& u, int wr, int wc, int fr, int fq) const {
        const int row0 = u.pm * BM + wr * 64 + fr, col0 = u.pn * HALF + wc * 32 + 8 * fq;
#pragma unroll
        for (int ai = 0; ai < 2; ++ai)
#pragma unroll
            for (int m = 0; m < 4; ++m) { const int row = row0 + ai * HALF + m * 16; const float rs = rsqrtf(ss[row] * (1.f / DM) + EPS);
                float h[8];
#pragma unroll
                for (int n = 0; n < 2; ++n)
#pragma unroll
                    for (int j = 0; j < 4; ++j) { const float g = acc[ai][0][m][n][j] * rs, uu = acc[ai][1][m][n][j] * rs; h[n * 4 + j] = g * sigmoidf_(g) * uu; }
                u32x4 w; w.x = cvt_pk_bf16(h[0], h[1]); w.y = cvt_pk_bf16(h[2], h[3]); w.z = cvt_pk_bf16(h[4], h[5]); w.w = cvt_pk_bf16(h[6], h[7]);
                *(u32x4*)(H + (size_t)row * DFF + col0) = w; }
    }
};
struct EpiPle {
    float* out; const bf16_t* pp; const float* ss2; float* ss3;
    __device__ __forceinline__ void operator()(const f32x4 (&acc)[2][2][4][2], const Unit& u, int wr, int wc, int fr, int fq) const {
        const int row0 = u.pm * BM + wr * 64 + fr, col0 = u.pn * BM + wc * 32 + 8 * fq;
#pragma unroll
        for (int ai = 0; ai < 2; ++ai)
#pragma unroll
            for (int m = 0; m < 4; ++m) { const int row = row0 + ai * HALF + m * 16; const bool live = row < MTOK; const float rs = rsqrtf(ss2[row] * (1.f / DM) + EPS);
                float q = 0.f;
                if (live) {
#pragma unroll
                for (int bj = 0; bj < 2; ++bj) { float* op = out + (size_t)row * DM + col0 + bj * HALF; const u32x4 pw = *(const u32x4*)(pp + (size_t)row * DM + col0 + bj * HALF);
                    f32x4 x0 = *(const f32x4*)op, x1 = *(const f32x4*)(op + 4); const f32x4 a0 = acc[ai][bj][m][0] * rs, a1 = acc[ai][bj][m][1] * rs;
                    x0[0] += sigmoidf_(a0[0]) * bflo(pw.x); x0[1] += sigmoidf_(a0[1]) * bfhi(pw.x); x0[2] += sigmoidf_(a0[2]) * bflo(pw.y); x0[3] += sigmoidf_(a0[3]) * bfhi(pw.y);
                    x1[0] += sigmoidf_(a1[0]) * bflo(pw.z); x1[1] += sigmoidf_(a1[1]) * bfhi(pw.z); x1[2] += sigmoidf_(a1[2]) * bflo(pw.w); x1[3] += sigmoidf_(a1[3]) * bfhi(pw.w);
                    *(f32x4*)op = x0; *(f32x4*)(op + 4) = x1;
                    q += (x0[0] * x0[0] + x0[1] * x0[1]) + (x0[2] * x0[2] + x0[3] * x0[3]) + (x1[0] * x1[0] + x1[1] * x1[1]) + (x1[2] * x1[2] + x1[3] * x1[3]); } }
                q += __shfl_xor(q, 16); q += __shfl_xor(q, 32);
                if (fq == 0 && live) atomicAdd(ss3 + row, q); }
    }
};

template <class Epi, bool ALIGN_EPI = true, bool SP2 = true>
__device__ __forceinline__ void gemm_phase(LAS unsigned char* lds, const Gemm g, const StaticOrder& S, const Epi& E) {
    const int tid = threadIdx.x, wid = __builtin_amdgcn_readfirstlane(tid >> 6), lane = tid & 63, wr = wid >> 2, wc = wid & 3, fr = lane & 15, fq = lane >> 4;
    const int K = g.K, nt = K / BK;
    unsigned voffA[2], voffB[2];
#pragma unroll
    for (int i = 0; i < 2; ++i) { int R, C; stage_rc(tid * 16 + i * 8192, R, C); const int Rb = (R & ~31) + perm32(R & 31);
        voffA[i] = (unsigned)(R * g.lda + C) * 2u; voffB[i] = (unsigned)(Rb * g.ldb + C) * 2u; }
    const size_t kstep = (size_t)(BK * 2);
    const size_t hstepA = (size_t)HALF * g.lda * 2, hstepB = (size_t)HALF * g.ldb * 2;
    const size_t tstepA = 2 * hstepA, tstepB = 2 * hstepB;
    const unsigned ldsw = (unsigned)wid * 1024u;
    const int aoff = lds_byte(wr * 64 + fr, fq * 8), boff = lds_byte(wc * 32 + fr, fq * 8);
#define PG8_SA(b, h) (((b) * 2 + (h)) * HTB)
#define PG8_SB(b, h) ((4 + (b) * 2 + (h)) * HTB)
#define PG8_STAGE(bufoff, gbase, voff) do { _Pragma("unroll") for (int _i = 0; _i < 2; ++_i) \
        __builtin_amdgcn_global_load_lds((const unsigned*)((const char*)(gbase) + (voff)[_i]), (LAS unsigned*)(lds + (bufoff) + ldsw + _i * 8192), 16, 0, 0); } while (0)
#define PG8_LDA(dst, b, h) do { _Pragma("unroll") for (int m = 0; m < 4; ++m) _Pragma("unroll") for (int k = 0; k < 2; ++k) dst[m][k] = *(const LAS bf16x8*)(lds + PG8_SA(b, h) + aoff + m * 2048 + k * 1024); } while (0)
#define PG8_LDB(dst, b, h) do { _Pragma("unroll") for (int n = 0; n < 2; ++n) _Pragma("unroll") for (int k = 0; k < 2; ++k) dst[n][k] = *(const LAS bf16x8*)(lds + PG8_SB(b, h) + boff + n * 2048 + k * 1024); } while (0)
#define PG8_MMA(ai, bj, At, Bt) do { __builtin_amdgcn_s_setprio(1); _Pragma("unroll") for (int m = 0; m < 4; ++m) _Pragma("unroll") for (int n = 0; n < 2; ++n) _Pragma("unroll") for (int k = 0; k < 2; ++k) \
        acc[ai][bj][m][n] = __builtin_amdgcn_mfma_f32_16x16x32_bf16(Bt[n][k], At[m][k], acc[ai][bj][m][n], 0, 0, 0); __builtin_amdgcn_s_setprio(0); } while (0)
#define PG8_WAIT_V(n) asm volatile("s_waitcnt vmcnt(" #n ")" ::: "memory")
#define PG8_WAIT_L(n) asm volatile("s_waitcnt lgkmcnt(" #n ")" ::: "memory")
#define PG8_BAR __builtin_amdgcn_s_barrier()
#define PG8_SCHED __builtin_amdgcn_sched_barrier(0)
    Unit cur, nxt; int ui = 0;
    if (!S.next(0, cur)) return;
    f32x4 acc[2][2][4][2];
#pragma unroll
    for (int a = 0; a < 2; ++a)
#pragma unroll
        for (int b = 0; b < 2; ++b)
#pragma unroll
            for (int m = 0; m < 4; ++m)
#pragma unroll
                for (int n = 0; n < 2; ++n) acc[a][b][m][n] = (f32x4){0.f, 0.f, 0.f, 0.f};
    bf16x8 At[4][2], B0[2][2], B1[2][2];
    const char* cA = (const char*)g.A + (size_t)cur.pm * tstepA + (size_t)((cur.pn / g.akdiv) * g.akmul) * 2; const char* cB = (const char*)g.Bt + (size_t)cur.pn * tstepB;
    if constexpr (SP2) {
        PG8_STAGE(PG8_SB(0, 0), cB, voffB); PG8_STAGE(PG8_SB(0, 1), cB + hstepB, voffB); PG8_STAGE(PG8_SA(0, 0), cA, voffA); PG8_STAGE(PG8_SA(0, 1), cA + hstepA, voffA);
        if (wr == 1) PG8_BAR;
        PG8_WAIT_V(2); PG8_BAR;
        PG8_STAGE(PG8_SB(1, 0), cB + kstep, voffB); PG8_STAGE(PG8_SA(1, 0), cA + kstep, voffA); PG8_STAGE(PG8_SB(1, 1), cB + hstepB + kstep, voffB);
        PG8_WAIT_V(6); PG8_BAR;
    } else {
        PG8_STAGE(PG8_SB(0, 0), cB, voffB); PG8_STAGE(PG8_SA(0, 0), cA, voffA); PG8_STAGE(PG8_SB(0, 1), cB + hstepB, voffB); PG8_STAGE(PG8_SA(0, 1), cA + hstepA, voffA);
        if (wr == 1) PG8_BAR;
        PG8_WAIT_V(4); PG8_BAR;
        PG8_STAGE(PG8_SB(1, 0), cB + kstep, voffB); PG8_STAGE(PG8_SA(1, 0), cA + kstep, voffA); PG8_STAGE(PG8_SB(1, 1), cB + hstepB + kstep, voffB);
        PG8_WAIT_V(6); PG8_BAR;
    }
    for (;;) {
        const bool has_next = S.next(ui + 1, nxt);
        const char* nA = has_next ? (const char*)g.A + (size_t)nxt.pm * tstepA + (size_t)((nxt.pn / g.akdiv) * g.akmul) * 2 : cA; const char* nB = has_next ? (const char*)g.Bt + (size_t)nxt.pn * tstepB : cB;
        for (int t = 0; t < nt; t += 2) {
            const bool last = (t == nt - 2);
            const char* a1 = cA + (size_t)(t + 1) * kstep;
            const char* a2 = last ? nA : cA + (size_t)(t + 2) * kstep; const char* b2 = last ? nB : cB + (size_t)(t + 2) * kstep;
            const char* a3 = a2 + kstep; const char* b3 = b2 + kstep;
            if constexpr (SP2) {
            PG8_LDB(B0, 0, 0); PG8_LDB(B1, 0, 1); PG8_SCHED; PG8_LDA(At, 0, 0); PG8_STAGE(PG8_SA(1, 1), a1 + hstepA, voffA);
            PG8_WAIT_V(8); PG8_WAIT_L(0); PG8_BAR; PG8_MMA(0, 0, At, B0); PG8_MMA(0, 1, At, B1); PG8_BAR; PG8_SCHED;
            PG8_LDA(At, 0, 1); PG8_STAGE(PG8_SB(0, 0), b2, voffB); PG8_STAGE(PG8_SB(0, 1), b2 + hstepB, voffB); PG8_STAGE(PG8_SA(0, 0), a2, voffA);
            PG8_WAIT_V(8); PG8_WAIT_L(0); PG8_BAR; PG8_MMA(1, 0, At, B0); PG8_MMA(1, 1, At, B1); PG8_BAR; PG8_SCHED;
            PG8_LDB(B0, 1, 0); PG8_LDB(B1, 1, 1); PG8_SCHED; PG8_LDA(At, 1, 0); PG8_STAGE(PG8_SA(0, 1), a2 + hstepA, voffA);
            PG8_WAIT_V(8); PG8_WAIT_L(0); PG8_BAR; PG8_MMA(0, 0, At, B0); PG8_MMA(0, 1, At, B1); PG8_BAR; PG8_SCHED;
            PG8_LDA(At, 1, 1); PG8_STAGE(PG8_SB(1, 0), b3, voffB); PG8_STAGE(PG8_SB(1, 1), b3 + hstepB, voffB); PG8_STAGE(PG8_SA(1, 0), a3, voffA);
            PG8_WAIT_V(8); PG8_WAIT_L(0); PG8_BAR; PG8_MMA(1, 0, At, B0); PG8_MMA(1, 1, At, B1); PG8_BAR; PG8_SCHED;
            } else {
            PG8_LDB(B0, 0, 0); PG8_SCHED; PG8_LDA(At, 0, 0); PG8_STAGE(PG8_SA(1, 1), a1 + hstepA, voffA);
            PG8_WAIT_L(8); PG8_BAR; PG8_WAIT_L(0); PG8_MMA(0, 0, At, B0); PG8_BAR; PG8_SCHED;
            PG8_LDB(B1, 0, 1); PG8_STAGE(PG8_SB(0, 0), b2, voffB);
            PG8_BAR; PG8_WAIT_L(0); PG8_MMA(0, 1, At, B1); PG8_BAR;
            PG8_LDA(At, 0, 1); PG8_STAGE(PG8_SA(0, 0), a2, voffA);
            PG8_BAR; PG8_WAIT_L(0); PG8_MMA(1, 0, At, B0); PG8_BAR; PG8_SCHED;
            PG8_STAGE(PG8_SB(0, 1), b2 + hstepB, voffB);
            PG8_WAIT_V(6); PG8_BAR; PG8_MMA(1, 1, At, B1); PG8_BAR;
            PG8_LDB(B0, 1, 0); PG8_SCHED; PG8_LDA(At, 1, 0); PG8_STAGE(PG8_SA(0, 1), a2 + hstepA, voffA);
            PG8_WAIT_L(8); PG8_BAR; PG8_WAIT_L(0); PG8_MMA(0, 0, At, B0); PG8_BAR; PG8_SCHED;
            PG8_LDB(B1, 1, 1); PG8_STAGE(PG8_SB(1, 0), b3, voffB);
            PG8_BAR; PG8_WAIT_L(0); PG8_MMA(0, 1, At, B1); PG8_BAR;
            PG8_LDA(At, 1, 1); PG8_STAGE(PG8_SA(1, 0), a3, voffA);
            PG8_BAR; PG8_WAIT_L(0); PG8_MMA(1, 0, At, B0); PG8_BAR; PG8_SCHED;
            PG8_STAGE(PG8_SB(1, 1), b3 + hstepB, voffB);
            PG8_WAIT_V(6); PG8_BAR; PG8_MMA(1, 1, At, B1); PG8_BAR;
            }
        }
        if constexpr (ALIGN_EPI) { if (wr == 0) PG8_BAR; }
        E(acc, cur, wr, wc, fr, fq);
        if (!has_next) break;
#pragma unroll
        for (int a = 0; a < 2; ++a)
#pragma unroll
            for (int b = 0; b < 2; ++b)
#pragma unroll
                for (int m = 0; m < 4; ++m)
#pragma unroll
                    for (int n = 0; n < 2; ++n) acc[a][b][m][n] = (f32x4){0.f, 0.f, 0.f, 0.f};
        cur = nxt; cA = nA; cB = nB; ++ui;
        if constexpr (ALIGN_EPI) { if (wr == 1) PG8_BAR; }
    }
    PG8_WAIT_V(0);
    if constexpr (!ALIGN_EPI) { if (wr == 0) PG8_BAR; }
    PG8_BAR;
#undef PG8_SA
#undef PG8_SB
#undef PG8_STAGE
#undef PG8_LDA
#undef PG8_LDB
#undef PG8_MMA
#undef PG8_WAIT_V
#undef PG8_WAIT_L
#undef PG8_BAR
#undef PG8_SCHED
}
}

struct Args { const float* in[31]; float* out; unsigned char* ws; int ph_lo, ph_hi; };
enum { I_XP = 0, I_XS, I_SWKV, I_SSHIFT, I_CK, I_CV, I_PP, I_PS, I_NMIX, I_WIN, I_MU, I_W0, I_W2, I_A0, I_A2, I_G2, I_KK, I_KA, I_RK, I_LNW, I_LNB, I_SINK, I_WOUT, I_NFFN, I_WGATE, I_WUP, I_WDOWN, I_NPLE, I_PGATE, I_PPROJ, I_FNORM };

__device__ __forceinline__ void p0_transpose_item(const float* W, int K, int N, bf16_t* WT, const float* gain, int mode, LAS float* scr, int item, int lane) {
    const int nblk = N / 32, kb = item / nblk, nb = item % nblk, k0 = 64 * kb, n0 = 32 * nb;
#pragma unroll 8
    for (int i = 0; i < 32; ++i) { const int kk = 2 * i + (lane >> 5); float v = W[(size_t)(k0 + kk) * N + n0 + (lane & 31)]; if (gain) v *= gain[k0 + kk]; scr[kk * 33 + (lane & 31)] = v; }
    LDS_WAIT(); asm volatile("" ::: "memory");
    const int c = lane & 7;
    const int rbase = mode == 0 ? n0 : ((n0 >> 7) * 256 + (n0 & 127) + (mode == 2 ? 128 : 0));
#pragma unroll
    for (int j = 0; j < 4; ++j) { const int n = (lane >> 3) + 8 * j; const LAS float* s = scr + (8 * c) * 33 + n;
        u32x4 o; o.x = pk2(s[0 * 33], s[1 * 33]); o.y = pk2(s[2 * 33], s[3 * 33]); o.z = pk2(s[4 * 33], s[5 * 33]); o.w = pk2(s[6 * 33], s[7 * 33]);
        *(u32x4*)(WT + (size_t)(rbase + n) * K + k0 + 8 * c) = o; }
    LDS_WAIT(); asm volatile("" ::: "memory");
}
__device__ __forceinline__ void p0_prologue(const Args& a, LAS unsigned char* lds, int G) {
    const int tid = threadIdx.x, lane = tid & 63, wave = __builtin_amdgcn_readfirstlane(tid >> 6);
    LAS float* scr = (LAS float*)(lds + wave * 16384);
    const int gw = blockIdx.x * 8 + wave, NGW = G * 8;
    unsigned char* ws = a.ws;
    constexpr int I_IN = 32 * (PROJ / 32), I_OUT = 32 * 64, I_G = 32 * (DFF / 32), I_D = (DFF / 64) * 64, I_PG = 32 * 64, I_PPJ = 4 * 64;
    constexpr int NITEMS = I_IN + I_OUT + 2 * I_G + I_D + I_PG + I_PPJ;
    for (int it = gw; it < NITEMS; it += NGW) {
        int r = it;
        if (r < I_IN) { p0_transpose_item(a.in[I_WIN], DM, PROJ, (bf16_t*)(ws + WS_WIN), nullptr, 0, scr, r, lane); continue; } r -= I_IN;
        if (r < I_OUT) { p0_transpose_item(a.in[I_WOUT], DM, DM, (bf16_t*)(ws + WS_WOUT), nullptr, 0, scr, r, lane); continue; } r -= I_OUT;
        if (r < I_G) { p0_transpose_item(a.in[I_WGATE], DM, DFF, (bf16_t*)(ws + WS_WGU), a.in[I_NFFN], 1, scr, r, lane); continue; } r -= I_G;
        if (r < I_G) { p0_transpose_item(a.in[I_WUP], DM, DFF, (bf16_t*)(ws + WS_WGU), a.in[I_NFFN], 2, scr, r, lane); continue; } r -= I_G;
        if (r < I_D) { p0_transpose_item(a.in[I_WDOWN], DFF, DM, (bf16_t*)(ws + WS_WD), nullptr, 0, scr, r, lane); continue; } r -= I_D;
        if (r < I_PG) { p0_transpose_item(a.in[I_PGATE], DM, DM, (bf16_t*)(ws + WS_WPG), a.in[I_NPLE], 0, scr, r, lane); continue; } r -= I_PG;
        p0_transpose_item(a.in[I_PPROJ], PLE, DM, (bf16_t*)(ws + WS_WPP), nullptr, 0, scr, r, lane);
    }
    const int gt = blockIdx.x * 512 + tid, NGT = G * 512;
    { u32x4* zp = (u32x4*)((bf16_t*)(ws + WS_WIN) + (size_t)PROJ * DM); for (int i = gt; i < (ZP - PROJ) * DM / 8; i += NGT) zp[i] = (u32x4){0u, 0u, 0u, 0u}; }
    { bf16_t* wl = (bf16_t*)(ws + WS_WLORA);
      for (int i = gt; i < 3 * 256 * 1024; i += NGT) { const int which = i / (256 * 1024), rem = i % (256 * 1024), k = rem / 1024, n = rem % 1024;
          const int kw = which == 2 ? 256 : 96; const float* W = which == 0 ? a.in[I_W2] : (which == 1 ? a.in[I_A2] : a.in[I_G2]);
          const float v = k < kw ? W[(size_t)k * 1024 + n] : 0.f; wl[((size_t)which * 1024 + n) * 256 + k] = (bf16_t)f2bf(v); } }
    { float* s1 = (float*)(ws + WS_SS1); float* s2 = (float*)(ws + WS_SS2); float* s3 = (float*)(ws + WS_SS3); for (int i = gt; i < MP; i += NGT) { s1[i] = 0.f; s2[i] = 0.f; s3[i] = 0.f; } }
    { bf16_t* hb = (bf16_t*)(ws + WS_HB); const float* gmix = a.in[I_NMIX];
      for (int m = gw; m < MP; m += NGW) {
          u32x2* o = (u32x2*)(hb + (size_t)m * DM) + lane;
          if (m >= MTOK) { for (int j = 0; j < 8; ++j) o[64 * j] = (u32x2){0u, 0u}; continue; }
          const f32x4* xr = (const f32x4*)(m < MPROMPT ? a.in[I_XP] + (size_t)m * DM : a.in[I_XS] + (size_t)(m - MPROMPT) * DM) + lane;
          f32x4 v[8]; float s = 0.f;
#pragma unroll
          for (int j = 0; j < 8; ++j) { v[j] = xr[64 * j]; s += (v[j].x * v[j].x + v[j].y * v[j].y) + (v[j].z * v[j].z + v[j].w * v[j].w); }
          const float rs = rsqrtf(wave_sum(s) * (1.f / DM) + EPS);
#pragma unroll
          for (int j = 0; j < 8; ++j) { const f32x4 gg = ((const f32x4*)gmix)[lane + 64 * j]; u32x2 w; w.x = pk2(v[j].x * rs * gg.x, v[j].y * rs * gg.y); w.y = pk2(v[j].z * rs * gg.z, v[j].w * rs * gg.w); o[64 * j] = w; }
      } }
}

__device__ __forceinline__ void p2_lora_prep(const Args& a, int G) {
    const int tid = threadIdx.x, lane = tid & 63, wave = tid >> 6, gw = blockIdx.x * 8 + wave, NGW = G * 8;
    const bf16_t* z = (const bf16_t*)(a.ws + WS_Z); bf16_t* al = (bf16_t*)(a.ws + WS_MIX); const float* mu = a.in[I_MU]; const float* sshift = a.in[I_SSHIFT];
    for (int m = gw; m < MP; m += NGW) {
        bf16_t* orow = al + (size_t)m * 768;
        const bool live = m < MTOK;
        const bool has_prev = m < MPROMPT && (m % SEQ) != 0;
#pragma unroll
        for (int jj = 0; jj < 12; ++jj) { const int j = lane + 64 * jj; const int seg = j >> 8, off = j & 255; const int zc = seg == 0 ? ZXW + off : (seg == 1 ? ZXA + off : ZXG + off);
            const bool data = live && (seg == 2 || off < 96);
            float o = 0.f;
            if (data) { const float cur = bf2f(z[(size_t)m * ZP + zc]); float prev = 0.f;
                if (has_prev) prev = bf2f(z[(size_t)(m - 1) * ZP + zc]); else if (m >= MPROMPT) prev = sshift[(size_t)(m - MPROMPT) * RWKV_PROJ + zc];
                const float xs = cur + (prev - cur) * mu[zc];
                if (seg == 0) { const float t = __expf(2.f * xs); o = 1.f - 2.f * __builtin_amdgcn_rcpf(t + 1.f); } else if (seg == 1) o = xs; else o = sigmoidf_(xs); }
            orow[j] = (bf16_t)f2bf(o); }
    }
}

constexpr int TC = 16;
constexpr int OP_TOK = 6 * 64;
struct RwkvConst { float mu_r, mu_k, mu_v, w0, a0, kkc, kac, rk; };
__device__ __forceinline__ float rwkv_prep_token(LAS float* op, int lane, const RwkvConst& c, float zr, float zk, float zv, float pr, float pk, float pv, float wl, float al) {
    const float r = zr + (pr - zr) * c.mu_r, k = zk + (pk - zk) * c.mu_k, v = zv + (pv - zv) * c.mu_v;
    const float av = sigmoidf_(c.a0 + al);
    const float x = c.w0 + wl;
    const float sp = (-x > 20.f) ? -x : __logf(1.f + __expf(-x));
    const float w = -sp - 0.5f, d = __expf(-__expf(w));
    const float kkr = k * c.kkc; const float ss = wave_sum(kkr * kkr); const float kk = kkr * rsqrtf(fmaxf(ss, 1e-24f));
    const float kh = k * (1.f + (av - 1.f) * c.kac), bb = kk * av;
    op[lane] = kk; op[64 + lane] = d; op[128 + lane] = bb; op[192 + lane] = kh; op[256 + lane] = r; op[320 + lane] = v;
    return wave_sum(r * kh * c.rk);
}
__device__ __forceinline__ RwkvConst rwkv_consts(const Args& a, int h, int lane) {
    const int j = h * 64 + lane; RwkvConst c;
    c.mu_r = a.in[I_MU][j]; c.mu_k = a.in[I_MU][1024 + j]; c.mu_v = a.in[I_MU][2048 + j]; c.w0 = a.in[I_W0][j]; c.a0 = a.in[I_A0][j]; c.kkc = a.in[I_KK][j]; c.kac = a.in[I_KA][j]; c.rk = a.in[I_RK][j];
    return c;
}
__device__ __forceinline__ float rwkv_step(f32x4& s, const LAS float* op, int k0, float vv) {
    const f32x4 kk = *(const LAS f32x4*)(op + k0), d = *(const LAS f32x4*)(op + 64 + k0), bb = *(const LAS f32x4*)(op + 128 + k0), kh = *(const LAS f32x4*)(op + 192 + k0), r = *(const LAS f32x4*)(op + 256 + k0);
    const float sa = -row16_sum((s[0] * kk[0] + s[1] * kk[1]) + (s[2] * kk[2] + s[3] * kk[3]));
    s[0] = s[0] * d[0] + sa * bb[0] + vv * kh[0]; s[1] = s[1] * d[1] + sa * bb[1] + vv * kh[1]; s[2] = s[2] * d[2] + sa * bb[2] + vv * kh[2]; s[3] = s[3] * d[3] + sa * bb[3] + vv * kh[3];
    return row16_sum((s[0] * r[0] + s[1] * r[1]) + (s[2] * r[2] + s[3] * r[3]));
}
__device__ __forceinline__ void scan_prompt_item(const Args& a, LAS unsigned char* lds, int item) {
    const int chain = item >> 1, half = item & 1, b = chain >> 4, h = chain & 15;
    const int tid = threadIdx.x, lane = tid & 63, wave = __builtin_amdgcn_readfirstlane(tid >> 6);
    const int vloc = tid >> 4, vrow = half * 32 + vloc, k0 = (tid & 15) * 4;
    LAS float* OP = (LAS float*)lds;
    LAS float* YB = (LAS float*)(lds + 2 * TC * OP_TOK * 4);
    const bf16_t* z = (const bf16_t*)(a.ws + WS_Z); const bf16_t* lo = (const bf16_t*)(a.ws + WS_LORA);
    float* ybuf = (float*)(a.ws + WS_HB); float* rkr = (float*)(a.ws + WS_RKR);
    const RwkvConst c = rwkv_consts(a, h, lane);
    const int j = h * 64 + lane;
    const size_t mrow0 = (size_t)b * SEQ;
    f32x4 s = {0.f, 0.f, 0.f, 0.f};
    unsigned short rp, kp, vp, r0, k0_, v0, r1, k1, v1, wl0, al0, wl1, al1;
#define SCAN_LOAD(cc) do { const int t0 = (cc) * TC + 2 * wave; const bf16_t* zr0 = z + (mrow0 + t0) * ZP + j; const bf16_t* l0 = lo + (mrow0 + t0) * 3072 + j; \
        r0 = zr0[0]; k0_ = zr0[1024]; v0 = zr0[2048]; r1 = zr0[ZP]; k1 = zr0[ZP + 1024]; v1 = zr0[ZP + 2048]; wl0 = l0[0]; al0 = l0[1024]; wl1 = l0[3072]; al1 = l0[3072 + 1024]; \
        if (t0 > 0) { rp = zr0[-ZP]; kp = zr0[-ZP + 1024]; vp = zr0[-ZP + 2048]; } else { rp = 0; kp = 0; vp = 0; } } while (0)
#define SCAN_PREP(cc) do { LAS float* op = OP + (((cc) & 1) * TC + 2 * wave) * OP_TOK; const int t0 = (cc) * TC + 2 * wave; \
        const float q0 = rwkv_prep_token(op, lane, c, bf2f(r0), bf2f(k0_), bf2f(v0), bf2f(rp), bf2f(kp), bf2f(vp), bf2f(wl0), bf2f(al0)); \
        const float q1 = rwkv_prep_token(op + OP_TOK, lane, c, bf2f(r1), bf2f(k1), bf2f(v1), bf2f(r0), bf2f(k0_), bf2f(v0), bf2f(wl1), bf2f(al1)); \
        if (half == 0 && lane == 0) { rkr[(mrow0 + t0) * 16 + h] = q0; rkr[(mrow0 + t0 + 1) * 16 + h] = q1; } } while (0)
    SCAN_LOAD(0); SCAN_PREP(0);
    __syncthreads();
    constexpr int NCH = SEQ / TC;
    for (int cc = 0; cc < NCH; ++cc) {
        if (cc + 1 < NCH) SCAN_LOAD(cc + 1);
        const LAS float* opc = OP + (cc & 1) * TC * OP_TOK; LAS float* yb = YB + (cc & 1) * TC * 32;
#pragma unroll
        for (int tt = 0; tt < TC; ++tt) { const float vv = opc[tt * OP_TOK + 320 + vrow]; const float y = rwkv_step(s, opc + tt * OP_TOK, k0, vv); if ((tid & 15) == 0) yb[tt * 32 + vloc] = y; }
        if (cc + 1 < NCH) SCAN_PREP(cc + 1);
        __syncthreads();
        { const int tt = tid >> 5, vv = tid & 31; ybuf[(mrow0 + cc * TC + tt) * 1024 + h * 64 + half * 32 + vv] = yb[tt * 32 + vv]; }
    }
#undef SCAN_LOAD
#undef SCAN_PREP
    *(f32x4*)(a.out + O_WKVP + ((size_t)(b * 16 + h) * 64 + vrow) * 64 + k0) = s;
    __syncthreads();
}
__device__ __forceinline__ void scan_sample_item(const Args& a, LAS unsigned char* lds, int bs) {
    const int tid = threadIdx.x, lane = tid & 63, wave = __builtin_amdgcn_readfirstlane(tid >> 6);
    LAS float* op = (LAS float*)lds + wave * OP_TOK;
    const bf16_t* z = (const bf16_t*)(a.ws + WS_Z); const bf16_t* lo = (const bf16_t*)(a.ws + WS_LORA);
    float* ybuf = (float*)(a.ws + WS_HB); float* rkr = (float*)(a.ws + WS_RKR);
    const size_t m = (size_t)MPROMPT + bs;
    const float* sh = a.in[I_SSHIFT] + (size_t)bs * RWKV_PROJ;
    const int k0 = (lane & 15) * 4;
    for (int hh = 0; hh < 2; ++hh) { const int h = 2 * wave + hh, j = h * 64 + lane;
        const RwkvConst c = rwkv_consts(a, h, lane);
        const bf16_t* zr = z + m * ZP + j; const bf16_t* l0 = lo + m * 3072 + j;
        const float q = rwkv_prep_token(op, lane, c, bf2f(zr[0]), bf2f(zr[1024]), bf2f(zr[2048]), sh[j], sh[1024 + j], sh[2048 + j], bf2f(l0[0]), bf2f(l0[1024]));
        if (lane == 0) rkr[m * 16 + h] = q;
        LDS_WAIT(); asm volatile("" ::: "memory");
        const float* sin_ = a.in[I_SWKV] + (size_t)(bs * 16 + h) * 4096; float* sout = a.out + O_WKVS + (size_t)(bs * 16 + h) * 4096;
#pragma unroll 4
        for (int rg = 0; rg < 16; ++rg) { const int row = rg * 4 + (lane >> 4);
            f32x4 s = *(const f32x4*)(sin_ + row * 64 + k0);
            const float y = rwkv_step(s, op, k0, op[320 + row]);
            *(f32x4*)(sout + row * 64 + k0) = s;
            if ((lane & 15) == 0) ybuf[m * 1024 + h * 64 + row] = y; }
        LDS_WAIT(); asm volatile("" ::: "memory");
    }
}

constexpr int AT_KS = 0, AT_VT = 32768, AT_VTS = 528, AT_P = AT_VT + 64 * AT_VTS, AT_PS = 336, AT_PW = 16 * AT_PS;
__device__ __forceinline__ void attn_prompt_unit(const Args& a, LAS unsigned char* lds, int unit) {
    const int kvh = unit & 3, nb = (unit >> 2) & 15, b = unit >> 6;
    const int tid = threadIdx.x, lane = tid & 63, wave = __builtin_amdgcn_readfirstlane(tid >> 6), c16 = lane & 15, g = lane >> 4;
    const bf16_t* z = (const bf16_t*)(a.ws + WS_Z); bf16_t* mix = (bf16_t*)(a.ws + WS_MIX);
    const long m0 = (long)b * SEQ + nb * 128;
    const long mk0 = m0 - 128;
#pragma unroll
    for (int i = 0; i < 4; ++i) { const int ch = tid + 512 * i, key = ch >> 3, cc = ch & 7;
        u32x4 kv = {0u, 0u, 0u, 0u}, vv = {0u, 0u, 0u, 0u};
        if (nb > 0 || key >= 128) { const bf16_t* zr = z + (size_t)(mk0 + key) * ZP + kvh * 64 + cc * 8; kv = *(const u32x4*)(zr + ZK); vv = *(const u32x4*)(zr + ZV); }
        *(LAS u32x4*)(lds + AT_KS + key * 128 + ((cc ^ (key & 7)) << 4)) = kv;
        LAS bf16_t* vt = (LAS bf16_t*)(lds + AT_VT) + (cc * 8) * (AT_VTS / 2) + key;
        vt[0 * (AT_VTS / 2)] = (bf16_t)(vv.x & 0xffff); vt[1 * (AT_VTS / 2)] = (bf16_t)(vv.x >> 16); vt[2 * (AT_VTS / 2)] = (bf16_t)(vv.y & 0xffff); vt[3 * (AT_VTS / 2)] = (bf16_t)(vv.y >> 16);
        vt[4 * (AT_VTS / 2)] = (bf16_t)(vv.z & 0xffff); vt[5 * (AT_VTS / 2)] = (bf16_t)(vv.z >> 16); vt[6 * (AT_VTS / 2)] = (bf16_t)(vv.w & 0xffff); vt[7 * (AT_VTS / 2)] = (bf16_t)(vv.w >> 16); }
    __syncthreads();
    LAS unsigned char* pb = lds + AT_P + wave * AT_PW;
    for (int it = 0; it < 4; ++it) {
        const int G = wave * 4 + it, hq = G >> 3, q16 = G & 7, head = kvh * 4 + hq, i0 = q16 * 16, ts = q16 < 6 ? q16 : 6;
        const float slope = exp2f(-0.5f * (float)(head + 1)), sink = a.in[I_SINK][head];
        bf16x8 qf[2];
        { const bf16_t* qp = z + (size_t)(m0 + i0 + c16) * ZP + ZQ + head * 64 + g * 8; qf[0] = *(const bf16x8*)qp; qf[1] = *(const bf16x8*)(qp + 32); }
        f32x4 sc[10];
#pragma unroll
        for (int t = 0; t < 10; ++t) { const int key = 16 * (ts + t) + c16; f32x4 acc = {0.f, 0.f, 0.f, 0.f};
#pragma unroll
            for (int ks = 0; ks < 2; ++ks) { const bf16x8 kf = *(const LAS bf16x8*)(lds + AT_KS + key * 128 + (((ks * 4 + g) ^ (key & 7)) << 4)); acc = __builtin_amdgcn_mfma_f32_16x16x32_bf16(qf[ks], kf, acc, 0, 0, 0); }
            sc[t] = acc; }
        float mx[4], den[4];
#pragma unroll
        for (int r = 0; r < 4; ++r) { float m = -3.0e38f;
#pragma unroll
            for (int t = 0; t < 10; ++t) { const int s = 16 * (ts + t) + c16, dist = i0 + 4 * g + r + 128 - s; const bool valid = dist >= 0 && dist < 128 && (nb > 0 || s >= 128);
                const float v = valid ? sc[t][r] * 0.125f - slope * (float)dist : -3.0e38f; sc[t][r] = v; m = fmaxf(m, v); }
            m = fmaxf(row16_max(m), sink); mx[r] = m; }
#pragma unroll
        for (int r = 0; r < 4; ++r) { float sum = 0.f;
#pragma unroll
            for (int t = 0; t < 10; ++t) { const float p = sc[t][r] > -1.0e38f ? __expf(sc[t][r] - mx[r]) : 0.f; sum += p;
                *(LAS bf16_t*)(pb + (4 * g + r) * AT_PS + (16 * t + c16) * 2) = (bf16_t)f2bf(p); }
            den[r] = row16_sum(sum) + __expf(sink - mx[r]); }
        LDS_WAIT(); asm volatile("" ::: "memory");
        f32x4 o[4];
#pragma unroll
        for (int dt = 0; dt < 4; ++dt) o[dt] = (f32x4){0.f, 0.f, 0.f, 0.f};
#pragma unroll
        for (int kt = 0; kt < 5; ++kt) { const bf16x8 pf = *(const LAS bf16x8*)(pb + c16 * AT_PS + kt * 64 + g * 16);
#pragma unroll
            for (int dt = 0; dt < 4; ++dt) { const bf16x8 vf = *(const LAS bf16x8*)(lds + AT_VT + (16 * dt + c16) * AT_VTS + (16 * ts + 32 * kt + 8 * g) * 2);
                o[dt] = __builtin_amdgcn_mfma_f32_16x16x32_bf16(pf, vf, o[dt], 0, 0, 0); } }
#pragma unroll
        for (int r = 0; r < 4; ++r) { const float inv = __builtin_amdgcn_rcpf(den[r]); bf16_t* orow = mix + (size_t)(m0 + i0 + 4 * g + r) * DM + 1024 + head * 64 + c16;
#pragma unroll
            for (int dt = 0; dt < 4; ++dt) orow[16 * dt] = (bf16_t)f2bf(o[dt][r] * inv); }
        LDS_WAIT(); asm volatile("" ::: "memory");
    }
    __syncthreads();
}
__device__ __forceinline__ void attn_sample_unit(const Args& a, LAS float* scl  , int unit, int lane) {
    const int kvh = unit & 3, bs = unit >> 2, ksub = lane >> 4, dq = (lane & 15) * 4;
    const bf16_t* z = (const bf16_t*)(a.ws + WS_Z); bf16_t* mix = (bf16_t*)(a.ws + WS_MIX);
    const size_t m = (size_t)MPROMPT + bs;
    const float* ck = a.in[I_CK]; const float* cv = a.in[I_CV]; float* ko = a.out + O_KS; float* vo = a.out + O_VS;
    f32x4 qv[4]; float slope[4], sink[4];
#pragma unroll
    for (int gq = 0; gq < 4; ++gq) { const int head = kvh * 4 + gq; const u32x2 w = *(const u32x2*)(z + m * ZP + ZQ + head * 64 + dq); qv[gq] = (f32x4){bflo(w.x), bfhi(w.x), bflo(w.y), bfhi(w.y)};
        slope[gq] = exp2f(-0.5f * (float)(head + 1)); sink[gq] = a.in[I_SINK][head]; }
    f32x4 knew; { const u32x2 w = *(const u32x2*)(z + m * ZP + ZK + kvh * 64 + dq); knew = (f32x4){bflo(w.x), bfhi(w.x), bflo(w.y), bfhi(w.y)}; }
#pragma unroll 4
    for (int it = 0; it < 32; ++it) { const int s = it * 4 + ksub;
        f32x4 kv = knew; if (s < 127) kv = *(const f32x4*)(ck + (((size_t)bs * 128 + s + 1) * 4 + kvh) * 64 + dq);
        *(f32x4*)(ko + (((size_t)bs * 128 + s) * 4 + kvh) * 64 + dq) = kv;
#pragma unroll
        for (int gq = 0; gq < 4; ++gq) { const float p = row16_sum((qv[gq][0] * kv[0] + qv[gq][1] * kv[1]) + (qv[gq][2] * kv[2] + qv[gq][3] * kv[3]));
            if ((lane & 15) == 0) scl[gq * 128 + s] = p * 0.125f - slope[gq] * (float)(127 - s); } }
    LDS_WAIT(); asm volatile("" ::: "memory");
#pragma unroll
    for (int gq = 0; gq < 4; ++gq) { const float v0 = scl[gq * 128 + lane], v1 = scl[gq * 128 + 64 + lane]; const float mxv = fmaxf(wave_max(fmaxf(v0, v1)), sink[gq]);
        const float p0 = __expf(v0 - mxv), p1 = __expf(v1 - mxv); const float inv = __builtin_amdgcn_rcpf(wave_sum(p0 + p1) + __expf(sink[gq] - mxv));
        scl[gq * 128 + lane] = p0 * inv; scl[gq * 128 + 64 + lane] = p1 * inv; }
    LDS_WAIT(); asm volatile("" ::: "memory");
    float o[4] = {0.f, 0.f, 0.f, 0.f};
    const float vnew = bf2f(z[m * ZP + ZV + kvh * 64 + lane]);
#pragma unroll 8
    for (int s = 0; s < 128; ++s) { float vv = vnew; if (s < 127) vv = cv[(((size_t)bs * 128 + s + 1) * 4 + kvh) * 64 + lane];
        vo[(((size_t)bs * 128 + s) * 4 + kvh) * 64 + lane] = vv;
#pragma unroll
        for (int gq = 0; gq < 4; ++gq) o[gq] += scl[gq * 128 + s] * vv; }
#pragma unroll
    for (int gq = 0; gq < 4; ++gq) mix[m * DM + 1024 + (kvh * 4 + gq) * 64 + lane] = (bf16_t)f2bf(o[gq]);
    LDS_WAIT(); asm volatile("" ::: "memory");
}
__device__ __forceinline__ void p4_mixers(const Args& a, LAS unsigned char* lds, int G) {
    const int tid = threadIdx.x, lane = tid & 63, wave = __builtin_amdgcn_readfirstlane(tid >> 6);
    for (int it = blockIdx.x; it < 256; it += G) scan_prompt_item(a, lds, it);
    for (int it = blockIdx.x; it < NSAMP; it += G) scan_sample_item(a, lds, it);
    __syncthreads();
    for (int u = blockIdx.x; u < 512; u += G) attn_prompt_unit(a, lds, u);
    for (int u = blockIdx.x * 8 + wave; u < 512; u += G * 8) attn_sample_unit(a, (LAS float*)lds + wave * 512, u, lane);
    const bf16_t* z = (const bf16_t*)(a.ws + WS_Z); const int gt = blockIdx.x * 512 + tid, NGT = G * 512;
    for (int i = gt; i < 8 * RWKV_PROJ; i += NGT) { const int b = i / RWKV_PROJ, c = i % RWKV_PROJ; a.out[O_SHP + i] = bf2f(z[((size_t)b * SEQ + SEQ - 1) * ZP + c]); }
    for (int i = gt; i < NSAMP * RWKV_PROJ; i += NGT) { const int b = i / RWKV_PROJ, c = i % RWKV_PROJ; a.out[O_SHS + i] = bf2f(z[((size_t)MPROMPT + b) * ZP + c]); }
    for (int i = gt; i < 8 * 128 * 256; i += NGT) { const int c = i & 255, s = (i >> 8) & 127, b = i >> 15; const bf16_t* zr = z + ((size_t)b * SEQ + SEQ - 128 + s) * ZP;
        a.out[O_KP + i] = bf2f(zr[ZK + c]); a.out[O_VP + i] = bf2f(zr[ZV + c]); }
}

__device__ __forceinline__ void p5_rwkv_post(const Args& a, int G) {
    const int tid = threadIdx.x, lane = tid & 63, wave = tid >> 6, gw = blockIdx.x * 8 + wave, NGW = G * 8;
    const bf16_t* z = (const bf16_t*)(a.ws + WS_Z); const bf16_t* lo = (const bf16_t*)(a.ws + WS_LORA); bf16_t* mix = (bf16_t*)(a.ws + WS_MIX);
    const float* ybuf = (const float*)(a.ws + WS_HB); const float* rkr = (const float*)(a.ws + WS_RKR);
    for (int q = gw; q < MTOK * 4; q += NGW) { const int m = q >> 2, hg = q & 3, head = hg * 4 + (lane >> 4), j = head * 64 + (lane & 15) * 4;
        const f32x4 y = *(const f32x4*)(ybuf + (size_t)m * 1024 + j);
        const u32x2 zc = *(const u32x2*)(z + (size_t)m * ZP + 2048 + j); const u32x2 gl = *(const u32x2*)(lo + (size_t)m * 3072 + 2048 + j);
        f32x4 pv = {0.f, 0.f, 0.f, 0.f};
        if (m >= MPROMPT) pv = *(const f32x4*)(a.in[I_SSHIFT] + (size_t)(m - MPROMPT) * RWKV_PROJ + 2048 + j);
        else if ((m % SEQ) != 0) { const u32x2 zp = *(const u32x2*)(z + (size_t)(m - 1) * ZP + 2048 + j); pv = (f32x4){bflo(zp.x), bfhi(zp.x), bflo(zp.y), bfhi(zp.y)}; }
        const f32x4 zv = {bflo(zc.x), bfhi(zc.x), bflo(zc.y), bfhi(zc.y)}; const f32x4 muv = *(const f32x4*)(a.in[I_MU] + 2048 + j);
        const f32x4 v = zv + (pv - zv) * muv;
        const float mean = row16_sum((y[0] + y[1]) + (y[2] + y[3])) * (1.f / 64.f); const f32x4 dy = y - mean;
        const float var = row16_sum((dy[0] * dy[0] + dy[1] * dy[1]) + (dy[2] * dy[2] + dy[3] * dy[3])) * (1.f / 64.f); const float rstd = rsqrtf(var + GN_EPS);
        const f32x4 lw = *(const f32x4*)(a.in[I_LNW] + j), lb = *(const f32x4*)(a.in[I_LNB] + j); const float bon = rkr[(size_t)m * 16 + head];
        const f32x4 gg = {bflo(gl.x), bfhi(gl.x), bflo(gl.y), bfhi(gl.y)};
        const f32x4 o = (dy * rstd * lw + lb + bon * v) * gg;
        u32x2 w; w.x = pk2(o[0], o[1]); w.y = pk2(o[2], o[3]); *(u32x2*)(mix + (size_t)m * DM + j) = w; }
}

__device__ __forceinline__ void p7_convert_p(const Args& a, int G) {
    bf16_t* pb = (bf16_t*)(a.ws + WS_PB); const int gt = blockIdx.x * 512 + threadIdx.x, NGT = G * 512;
    for (int i = gt; i < MP * PLE / 4; i += NGT) { const int m = i / (PLE / 4), c4 = i % (PLE / 4); f32x4 v = {0.f, 0.f, 0.f, 0.f};
        if (m < MPROMPT) v = ((const f32x4*)a.in[I_PP])[(size_t)m * (PLE / 4) + c4]; else if (m < MTOK) v = ((const f32x4*)a.in[I_PS])[(size_t)(m - MPROMPT) * (PLE / 4) + c4];
        u32x2 w; w.x = pk2(v[0], v[1]); w.y = pk2(v[2], v[3]); ((u32x2*)pb)[i] = w; }
}
__device__ __forceinline__ void p10_final_norm(const Args& a, int G) {
    const int tid = threadIdx.x, lane = tid & 63, wave = tid >> 6, gw = blockIdx.x * 8 + wave, NGW = G * 8; const float* ss3 = (const float*)(a.ws + WS_SS3);
    for (int m = gw; m < MTOK; m += NGW) { const float rs = rsqrtf(ss3[m] * (1.f / DM) + EPS); f32x4* xr = (f32x4*)(a.out + (size_t)m * DM) + lane;
#pragma unroll
        for (int j = 0; j < 8; ++j) { const f32x4 gg = ((const f32x4*)a.in[I_FNORM])[lane + 64 * j]; xr[64 * j] = xr[64 * j] * rs * gg; } }
}

__global__ void __launch_bounds__(512, 2) mk_fwd(Args a) {
    extern __shared__ __attribute__((aligned(16))) unsigned char lds_raw[];
    LAS unsigned char* lds = (LAS unsigned char*)lds_raw;
    const int G = gridDim.x; unsigned char* ws = a.ws;
    const int lo = a.ph_lo, hi = a.ph_hi;
#define IN(k) (lo <= (k) && (k) < hi)
#define SEAM(k) do { if (IN(k) && IN((k) + 1)) { __syncthreads(); } } while (0)
    if (IN(0)) { p0_prologue(a, lds, G); }
    SEAM(0);
    if (IN(1)) { pg8::Gemm g{(const bf16_t*)(ws + WS_HB), (const bf16_t*)(ws + WS_WIN), MP, ZP, DM, DM, DM, 1 << 30, 0}; pg8::StaticOrder S; S.init(MP, ZP, G, (int)blockIdx.x);
        pg8::EpiBf16 E{(bf16_t*)(ws + WS_Z), ZP}; pg8::gemm_phase<pg8::EpiBf16>(lds, g, S, E); }
    SEAM(1);
    if (IN(2)) { p2_lora_prep(a, G); }
    SEAM(2);
    if (IN(3)) { pg8::Gemm g{(const bf16_t*)(ws + WS_MIX), (const bf16_t*)(ws + WS_WLORA), MP, 3072, 256, 768, 256, 4, 256}; pg8::StaticOrder S; S.init(MP, 3072, G, (int)blockIdx.x);
        pg8::EpiBf16 E{(bf16_t*)(ws + WS_LORA), 3072}; pg8::gemm_phase<pg8::EpiBf16>(lds, g, S, E); }
    SEAM(3);
    if (IN(4)) { p4_mixers(a, lds, G); }
    SEAM(4);
    if (IN(5)) { p5_rwkv_post(a, G); }
    SEAM(5);
    if (IN(6)) { pg8::Gemm g{(const bf16_t*)(ws + WS_MIX), (const bf16_t*)(ws + WS_WOUT), MP, DM, DM, DM, DM, 1 << 30, 0}; pg8::StaticOrder S; S.init(MP, DM, G, (int)blockIdx.x);
        pg8::EpiResid E{a.in[I_XP], a.in[I_XS], a.out, (bf16_t*)(ws + WS_HB), (float*)(ws + WS_SS1)}; pg8::gemm_phase<pg8::EpiResid>(lds, g, S, E); }
    SEAM(6);
    if (IN(7)) { p7_convert_p(a, G);
        pg8::Gemm g{(const bf16_t*)(ws + WS_HB), (const bf16_t*)(ws + WS_WGU), MP, 2 * DFF, DM, DM, DM, 1 << 30, 0}; pg8::StaticOrder S; S.init(MP, 2 * DFF, G, (int)blockIdx.x);
        pg8::EpiGateUp E{(bf16_t*)(ws + WS_HID), (const float*)(ws + WS_SS1)}; pg8::gemm_phase<pg8::EpiGateUp>(lds, g, S, E); }
    SEAM(7);
    if (IN(8)) { pg8::Gemm g{(const bf16_t*)(ws + WS_HID), (const bf16_t*)(ws + WS_WD), MP, DM, DFF, DFF, DFF, 1 << 30, 0}; pg8::StaticOrder S; S.init(MP, DM, G, (int)blockIdx.x);
        pg8::EpiResid E{a.out, a.out + (size_t)MPROMPT * DM, a.out, (bf16_t*)(ws + WS_HB), (float*)(ws + WS_SS2)}; pg8::gemm_phase<pg8::EpiResid>(lds, g, S, E); }
    SEAM(8);
    if (IN(9)) { pg8::StaticOrder S; S.init(MP, DM, G, (int)blockIdx.x);
        { pg8::Gemm g{(const bf16_t*)(ws + WS_PB), (const bf16_t*)(ws + WS_WPP), MP, DM, PLE, PLE, PLE, 1 << 30, 0}; pg8::EpiBf16 E{(bf16_t*)(ws + WS_MIX), DM}; pg8::gemm_phase<pg8::EpiBf16>(lds, g, S, E); }
        { pg8::Gemm g{(const bf16_t*)(ws + WS_HB), (const bf16_t*)(ws + WS_WPG), MP, DM, DM, DM, DM, 1 << 30, 0};
          pg8::EpiPle E{a.out, (const bf16_t*)(ws + WS_MIX), (const float*)(ws + WS_SS2), (float*)(ws + WS_SS3)}; pg8::gemm_phase<pg8::EpiPle>(lds, g, S, E); } }
    SEAM(9);
    if (IN(10)) { p10_final_norm(a, G); }
#undef IN
#undef SEAM
}

extern "C" void kernel_launch(void* const* d_in, const int* in_sizes, int n_in, void* d_out, int out_size, void* d_ws, size_t ws_size, hipStream_t stream) {
    static int grid = 0;
    if (grid == 0) {
        if (n_in != 31 || ws_size < WS_END) { fprintf(stderr, "kernel_launch: expected 31 inputs and >= %zu bytes of workspace, got %d / %zu\n", (size_t)WS_END, n_in, ws_size); grid = -1; return; }
        int dev = 0, cus = 0;
        if (hipGetDevice(&dev) != hipSuccess || hipDeviceGetAttribute(&cus, hipDeviceAttributeMultiprocessorCount, dev) != hipSuccess) { grid = -1; return; }
        if (hipFuncSetAttribute((const void*)mk_fwd, hipFuncAttributeMaxDynamicSharedMemorySize, LDS_BYTES) != hipSuccess) { fprintf(stderr, "kernel_launch: hipFuncSetAttribute failed\n"); grid = -1; return; }
        grid = cus;
    }
    if (grid < 0) return;
    Args a{};
    for (int i = 0; i < 31; ++i) a.in[i] = (const float*)d_in[i];
    a.out = (float*)d_out; a.ws = (unsigned char*)d_ws;
    for (int p = 0; p < NPHASE; ++p) { a.ph_lo = p; a.ph_hi = p + 1; hipLaunchKernelGGL(mk_fwd, dim3(grid), dim3(512), LDS_BYTES, stream, a); }
}
```

```cpp
#include <hip/hip_runtime.h>
#include <cstdio>
#include <cstdint>

#define GAS __attribute__((address_space(1)))
#define LAS __attribute__((address_space(3)))
typedef unsigned short bf16_t;
typedef short bf16x8 __attribute__((ext_vector_type(8)));
typedef float f32x4 __attribute__((ext_vector_type(4)));
typedef float f32x2 __attribute__((ext_vector_type(2)));
typedef unsigned u32x4 __attribute__((ext_vector_type(4)));
typedef unsigned u32x2 __attribute__((ext_vector_type(2)));

#ifndef MK_DUP
#define MK_DUP 0
#endif
#ifndef MK_ONE_LAUNCH
#define MK_ONE_LAUNCH 1
#endif

constexpr int DM = 2048, SEQ = 2048, MPROMPT = 16384, NSAMP = 128, MTOK = 16512, MP = 16640;
constexpr int ZP = 5120, PROJ = 5056, RWKV_PROJ = 3520, DFF = 5632, PLE = 256;
constexpr int ZQ = 3520, ZK = 4544, ZV = 4800;
constexpr int ZXW = 3072, ZXA = 3168, ZXG = 3264;
constexpr float EPS = 1e-6f, GN_EPS = 64e-5f;
constexpr size_t O_Y = 0, O_WKVP = 33816576, O_SHP = 34340864, O_KP = 34369024, O_VP = 34631168, O_WKVS = 34893312, O_SHS = 43281920, O_KS = 43732480, O_VS = 47926784;
constexpr size_t MiB = 1u << 20;
constexpr size_t WS_CTL = 0, WS_SS1 = 1 * MiB, WS_SS2 = 1 * MiB + 131072, WS_SS3 = 1 * MiB + 262144, WS_RKR = 2 * MiB;
constexpr size_t WS_WIN = 4 * MiB, WS_WOUT = 24 * MiB, WS_WGU = 32 * MiB, WS_WD = 76 * MiB, WS_WPG = 98 * MiB, WS_WPP = 106 * MiB, WS_WLORA = 107 * MiB;
constexpr size_t WS_HB = 109 * MiB, WS_Z = 174 * MiB, WS_LORA = WS_Z + (size_t)MP * ZP * 2, WS_MIX = 434 * MiB, WS_PB = 499 * MiB, WS_END = 508 * MiB;
constexpr size_t WS_HID = WS_Z, WS_X3 = WS_LORA + 32 * MiB;
static_assert(WS_X3 >= WS_HID + (size_t)MP * DFF * 2 && WS_X3 + (size_t)MP * DM * 2 <= WS_MIX, "ws map 3");
static_assert(WS_LORA + (size_t)MP * 3072 * 2 <= WS_MIX, "ws map");
static_assert(WS_MIX + (size_t)MP * DM * 2 <= WS_PB && WS_PB + (size_t)MP * PLE * 2 <= WS_END, "ws map 2");
constexpr int LDS_BYTES = 147456;
constexpr int NPHASE = 11;

typedef __bf16 bf16x2_t __attribute__((ext_vector_type(2)));
__device__ __forceinline__ unsigned pk2(float lo, float hi) { const f32x2 f = {lo, hi}; return __builtin_bit_cast(unsigned, __builtin_convertvector(f, bf16x2_t)); }
__device__ __forceinline__ unsigned f2bf(float f) { return pk2(f, 0.f) & 0xffffu; }
__device__ __forceinline__ float bf2f(unsigned b) { return __uint_as_float(b << 16); }
__device__ __forceinline__ float bflo(unsigned w) { return __uint_as_float(w << 16); }
__device__ __forceinline__ float bfhi(unsigned w) { return __uint_as_float(w & 0xffff0000u); }
__device__ __forceinline__ unsigned cvt_pk_bf16(float lo, float hi) { return pk2(lo, hi); }
template <int CTRL> __device__ __forceinline__ float dpp_f(float x) { return __int_as_float(__builtin_amdgcn_update_dpp(0, __float_as_int(x), CTRL, 0xf, 0xf, true)); }
__device__ __forceinline__ float row16_sum(float x) { x += dpp_f<0xB1>(x); x += dpp_f<0x4E>(x); x += dpp_f<0x124>(x); x += dpp_f<0x128>(x); return x; }
__device__ __forceinline__ float row8_sum(float x) { x += dpp_f<0xB1>(x); x += dpp_f<0x4E>(x); x += dpp_f<0x141>(x); return x; }
__device__ __forceinline__ float row16_max(float x) { x = fmaxf(x, dpp_f<0xB1>(x)); x = fmaxf(x, dpp_f<0x4E>(x)); x = fmaxf(x, dpp_f<0x124>(x)); x = fmaxf(x, dpp_f<0x128>(x)); return x; }
__device__ __forceinline__ float wave_sum(float v) { v = row16_sum(v); v += __shfl_xor(v, 16); v += __shfl_xor(v, 32); return v; }
__device__ __forceinline__ float wave_max(float v) { v = row16_max(v); v = fmaxf(v, __shfl_xor(v, 16)); v = fmaxf(v, __shfl_xor(v, 32)); return v; }
__device__ __forceinline__ float sigmoidf_(float x) { return __builtin_amdgcn_rcpf(1.f + __expf(-x)); }
__device__ __forceinline__ f32x4 bf4(u32x2 w) { return (f32x4){bflo(w.x), bfhi(w.x), bflo(w.y), bfhi(w.y)}; }
#define LDS_WAIT() asm volatile("s_waitcnt lgkmcnt(0)" ::: "memory")

namespace pg8 {
constexpr int BM = 256, BK = 64, HALF = 128, HTB = HALF * BK * 2, STAGE_BYTES = 8 * HTB, NXCD = 8, WGM = 2;
__host__ __device__ __forceinline__ int lds_byte(int r, int c) { const int st = (r >> 4) * 2 + (c >> 5), rr = r & 15, cc = c & 31, ob = rr * 64 + cc * 2; return st * 1024 + (ob ^ (((ob >> 9) & 1) << 5)); }
__host__ __device__ __forceinline__ void stage_rc(int b, int& R, int& C) { const int st = b / 1024, sb = b % 1024, swz = sb ^ (((sb >> 9) & 1) << 5); R = (st >> 1) * 16 + swz / 64; C = (st & 1) * 32 + (swz % 64) / 2; }
__host__ __device__ __forceinline__ int perm32(int rho) { const int n = rho >> 4, i = rho & 15; return 8 * (i >> 2) + 4 * n + (i & 3); }
struct Unit { int pm, pn, mode;
    __device__ __forceinline__ int cb() const { return mode == 2 ? pn * HALF : pn * BM; } };
struct Gemm { const bf16_t* A; const bf16_t* Bt; int M, N, K, lda, ldb, akdiv, akmul; };
struct StaticOrder {
    int nM, nN, nwg, G, c, nreg, half_pm, fold_pm;
    __host__ __device__ void init(int M, int N, int G_, int c_, int half_pm_ = -1, int nfold = 0, int fold_pm_ = 0) { nM = M / BM; nN = N / BM; nreg = nM * nN; nwg = nreg + nfold; G = G_; c = c_; half_pm = half_pm_; fold_pm = fold_pm_; }
    __host__ __device__ bool next(int i, Unit& u) const {
        const long L = (long)i * G + c; if (L >= nwg) return false;
        if (L >= nreg) { u.pm = fold_pm; u.pn = (int)L - nreg; u.mode = 2; return true; }
        int wgid = (int)L; { const int q = nreg / NXCD, r = nreg % NXCD, xcd = wgid % NXCD, off = wgid / NXCD; wgid = (xcd < r ? xcd * (q + 1) : r * (q + 1) + (xcd - r) * q) + off; }
        const int nig = WGM * nN, gid = wgid / nig, fm = gid * WGM, gsz = (nM - fm) < WGM ? (nM - fm) : WGM;
        u.pm = fm + ((wgid % nig) % gsz); u.pn = (wgid % nig) / gsz; u.mode = (u.pm == half_pm) ? 1 : 0; return true;
    }
};
struct EpiBf16 {
    bf16_t* O; int ldc;
    __device__ __forceinline__ void operator()(const f32x4 (&acc)[2][2][4][2], const Unit& u, int wr, int wc, int fr, int fq) const {
        const int row0 = u.pm * BM + wr * 64 + fr, col0 = u.cb() + wc * 32 + 8 * fq; const bool fold = u.mode == 2;
#pragma unroll
        for (int ai = 0; ai < 2; ++ai)
#pragma unroll
            for (int m = 0; m < 4; ++m) { bf16_t* rowp = O + (size_t)(row0 + ai * HALF + m * 16) * ldc + col0;
#pragma unroll
                for (int bj = 0; bj < 2; ++bj) { if (fold && (ai | bj)) continue; const f32x4 v0 = acc[ai][bj][m][0], v1 = acc[ai][bj][m][1];
                    u32x4 w; w.x = cvt_pk_bf16(v0[0], v0[1]); w.y = cvt_pk_bf16(v0[2], v0[3]); w.z = cvt_pk_bf16(v1[0], v1[1]); w.w = cvt_pk_bf16(v1[2], v1[3]);
                    *(u32x4*)(rowp + bj * HALF) = w; } }
    }
};
struct EpiLora {
    bf16_t* O; const float* w0; const float* a0;
    __device__ __forceinline__ void operator()(const f32x4 (&acc)[2][2][4][2], const Unit& u, int wr, int wc, int fr, int fq) const {
        const int row0 = u.pm * BM + wr * 64 + fr, col0 = u.pn * BM + wc * 32 + 8 * fq, kind = u.pn >> 2, cb = (u.pn & 3) * BM + wc * 32 + 8 * fq;
        const float* bias = (kind == 0 ? w0 : a0) + cb; const float sc = kind == 0 ? 0.60653066f : 1.f;
#pragma unroll
        for (int bj = 0; bj < 2; ++bj) {
            f32x4 b0 = {0.f, 0.f, 0.f, 0.f}, b1 = {0.f, 0.f, 0.f, 0.f};
            if (kind < 2) { b0 = *(const f32x4*)(bias + bj * HALF); b1 = *(const f32x4*)(bias + bj * HALF + 4); }
#pragma unroll
            for (int ai = 0; ai < 2; ++ai)
#pragma unroll
                for (int m = 0; m < 4; ++m) { bf16_t* rowp = O + (size_t)(row0 + ai * HALF + m * 16) * 3072 + col0 + bj * HALF;
                    f32x4 v0 = acc[ai][bj][m][0] + b0, v1 = acc[ai][bj][m][1] + b1;
                    if (kind < 2) {
#pragma unroll
                        for (int j = 0; j < 4; ++j) { v0[j] = sc * sigmoidf_(v0[j]); v1[j] = sc * sigmoidf_(v1[j]); } }
                    u32x4 w; w.x = cvt_pk_bf16(v0[0], v0[1]); w.y = cvt_pk_bf16(v0[2], v0[3]); w.z = cvt_pk_bf16(v1[0], v1[1]); w.w = cvt_pk_bf16(v1[2], v1[3]);
                    *(u32x4*)rowp = w; } }
    }
};
struct EpiResid {
    const float* xp; const float* xs; bf16_t* xb; float* ss;
    __device__ __forceinline__ void operator()(const f32x4 (&acc)[2][2][4][2], const Unit& u, int wr, int wc, int fr, int fq) const {
        const int row0 = u.pm * BM + wr * 64 + fr, col0 = u.cb() + wc * 32 + 8 * fq; const bool fold = u.mode == 2;
#pragma unroll
        for (int ai = 0; ai < 2; ++ai)
#pragma unroll
            for (int mp = 0; mp < 2; ++mp) {
                if (fold && ai) continue;
                f32x4 o[2][2][2]; bool live[2]; int rows[2];
#pragma unroll
                for (int mm = 0; mm < 2; ++mm) { const int row = row0 + ai * HALF + (2 * mp + mm) * 16; rows[mm] = row; live[mm] = row < MTOK; const int rl = live[mm] ? row : 0;
                    if (xp) { const float* src = (rl < MPROMPT ? xp + (size_t)rl * DM : xs + (size_t)(rl - MPROMPT) * DM) + col0;
#pragma unroll
                        for (int bj = 0; bj < 2; ++bj) { if (fold && bj) continue; o[mm][bj][0] = *(const f32x4*)(src + bj * HALF); o[mm][bj][1] = *(const f32x4*)(src + bj * HALF + 4); } }
                    else {
#pragma unroll
                        for (int bj = 0; bj < 2; ++bj) { if (fold && bj) continue; const u32x4 w = *(const u32x4*)(xb + (size_t)rl * DM + col0 + bj * HALF);
                            o[mm][bj][0] = (f32x4){bflo(w.x), bfhi(w.x), bflo(w.y), bfhi(w.y)}; o[mm][bj][1] = (f32x4){bflo(w.z), bfhi(w.z), bflo(w.w), bfhi(w.w)}; } } }
#pragma unroll
                for (int mm = 0; mm < 2; ++mm) { const int m = 2 * mp + mm, row = rows[mm]; float q = 0.f;
#pragma unroll
                    for (int bj = 0; bj < 2; ++bj) { if (fold && bj) continue; const f32x4 v0 = acc[ai][bj][m][0] + o[mm][bj][0], v1 = acc[ai][bj][m][1] + o[mm][bj][1];
                        q += (v0[0] * v0[0] + v0[1] * v0[1]) + (v0[2] * v0[2] + v0[3] * v0[3]) + (v1[0] * v1[0] + v1[1] * v1[1]) + (v1[2] * v1[2] + v1[3] * v1[3]);
                        u32x4 w; w.x = cvt_pk_bf16(v0[0], v0[1]); w.y = cvt_pk_bf16(v0[2], v0[3]); w.z = cvt_pk_bf16(v1[0], v1[1]); w.w = cvt_pk_bf16(v1[2], v1[3]);
                        if (live[mm]) *(u32x4*)(xb + (size_t)row * DM + col0 + bj * HALF) = w; }
                    q += __shfl_xor(q, 16); q += __shfl_xor(q, 32);
                    if (fq == 0 && live[mm]) atomicAdd(ss + row, q); } }
    }
};
struct EpiGateUp {
    bf16_t* H; const float* ss;
    __device__ __forceinline__ void operator()(const f32x4 (&acc)[2][2][4][2], const Unit& u, int wr, int wc, int fr, int fq) const {
        const int row0 = u.pm * BM + wr * 64 + fr, colh = (u.cb() + wc * 32 + 8 * fq) >> 1; const bool fold = u.mode == 2;
#pragma unroll
        for (int ai = 0; ai < 2; ++ai)
#pragma unroll
            for (int m = 0; m < 4; ++m) { if (fold && ai) continue; const int row = row0 + ai * HALF + m * 16; const float rs = rsqrtf(ss[row] * (1.f / DM) + EPS);
#pragma unroll
                for (int bj = 0; bj < 2; ++bj) { if (fold && bj) continue; float h[4];
#pragma unroll
                    for (int j = 0; j < 4; ++j) { const float g = acc[ai][bj][m][0][j] * rs, uu = acc[ai][bj][m][1][j] * rs; h[j] = g * sigmoidf_(g) * uu; }
                    u32x2 w; w.x = cvt_pk_bf16(h[0], h[1]); w.y = cvt_pk_bf16(h[2], h[3]);
                    *(u32x2*)(H + (size_t)row * DFF + colh + bj * 64) = w; } }
    }
};
struct EpiPle {
    const bf16_t* x2b; bf16_t* x3b; const bf16_t* pp; const float* ss2; float* ss3;
    __device__ __forceinline__ void operator()(const f32x4 (&acc)[2][2][4][2], const Unit& u, int wr, int wc, int fr, int fq) const {
        const int row0 = u.pm * BM + wr * 64 + fr, col0 = u.cb() + wc * 32 + 8 * fq; const bool fold = u.mode == 2;
#pragma unroll
        for (int ai = 0; ai < 2; ++ai)
#pragma unroll
            for (int mp = 0; mp < 2; ++mp) {
                if (fold && ai) continue;
                u32x4 xw[2][2], pw[2][2]; bool live[2]; int rows[2]; float rs[2];
#pragma unroll
                for (int mm = 0; mm < 2; ++mm) { const int row = row0 + ai * HALF + (2 * mp + mm) * 16; rows[mm] = row; live[mm] = row < MTOK; const int rl = live[mm] ? row : 0;
                    rs[mm] = rsqrtf(ss2[rl] * (1.f / DM) + EPS);
#pragma unroll
                    for (int bj = 0; bj < 2; ++bj) { if (fold && bj) continue; xw[mm][bj] = *(const u32x4*)(x2b + (size_t)rl * DM + col0 + bj * HALF); pw[mm][bj] = *(const u32x4*)(pp + (size_t)rl * DM + col0 + bj * HALF); } }
#pragma unroll
                for (int mm = 0; mm < 2; ++mm) { const int m = 2 * mp + mm, row = rows[mm]; float q = 0.f;
#pragma unroll
                    for (int bj = 0; bj < 2; ++bj) { if (fold && bj) continue; const u32x4 xx = xw[mm][bj], p = pw[mm][bj]; const f32x4 a0 = acc[ai][bj][m][0] * rs[mm], a1 = acc[ai][bj][m][1] * rs[mm];
                        f32x4 x0 = {bflo(xx.x), bfhi(xx.x), bflo(xx.y), bfhi(xx.y)}, x1 = {bflo(xx.z), bfhi(xx.z), bflo(xx.w), bfhi(xx.w)};
                        x0[0] += sigmoidf_(a0[0]) * bflo(p.x); x0[1] += sigmoidf_(a0[1]) * bfhi(p.x); x0[2] += sigmoidf_(a0[2]) * bflo(p.y); x0[3] += sigmoidf_(a0[3]) * bfhi(p.y);
                        x1[0] += sigmoidf_(a1[0]) * bflo(p.z); x1[1] += sigmoidf_(a1[1]) * bfhi(p.z); x1[2] += sigmoidf_(a1[2]) * bflo(p.w); x1[3] += sigmoidf_(a1[3]) * bfhi(p.w);
                        u32x4 w; w.x = cvt_pk_bf16(x0[0], x0[1]); w.y = cvt_pk_bf16(x0[2], x0[3]); w.z = cvt_pk_bf16(x1[0], x1[1]); w.w = cvt_pk_bf16(x1[2], x1[3]);
                        if (live[mm]) *(u32x4*)(x3b + (size_t)row * DM + col0 + bj * HALF) = w;
                        q += (x0[0] * x0[0] + x0[1] * x0[1]) + (x0[2] * x0[2] + x0[3] * x0[3]) + (x1[0] * x1[0] + x1[1] * x1[1]) + (x1[2] * x1[2] + x1[3] * x1[3]); }
                    q += __shfl_xor(q, 16); q += __shfl_xor(q, 32);
                    if (fq == 0 && live[mm]) atomicAdd(ss3 + row, q); } }
    }
};

template <class Epi, bool ALIGN_EPI = true, bool SP2 = true>
__device__ __forceinline__ void gemm_phase(LAS unsigned char* lds, const Gemm g, const StaticOrder& S, const Epi& E) {
    const int tid = threadIdx.x, wid = __builtin_amdgcn_readfirstlane(tid >> 6), lane = tid & 63, wr = wid >> 2, wc = wid & 3, fr = lane & 15, fq = lane >> 4;
    const int K = g.K, nt = K / BK;
    unsigned voffA[2], voffB[2];
#pragma unroll
    for (int i = 0; i < 2; ++i) { int R, C; stage_rc(tid * 16 + i * 8192, R, C); const int Rb = (R & ~31) + perm32(R & 31);
        voffA[i] = (unsigned)(R * g.lda + C) * 2u; voffB[i] = (unsigned)(Rb * g.ldb + C) * 2u; }
    const size_t kstep = (size_t)(BK * 2);
    const size_t hstepA = (size_t)HALF * g.lda * 2, hstepB = (size_t)HALF * g.ldb * 2;
    const size_t tstepA = 2 * hstepA, tstepB = 2 * hstepB;
    const unsigned ldsw = (unsigned)wid * 1024u;
    const int aoff = lds_byte(wr * 64 + fr, fq * 8), boff = lds_byte(wc * 32 + fr, fq * 8);
#define PG8_SA(b, h) (((b) * 2 + (h)) * HTB)
#define PG8_SB(b, h) ((4 + (b) * 2 + (h)) * HTB)
#define PG8_STAGE(bufoff, gbase, voff) do { _Pragma("unroll") for (int _i = 0; _i < 2; ++_i) \
        __builtin_amdgcn_global_load_lds((const unsigned*)((const char*)(gbase) + (voff)[_i]), (LAS unsigned*)(lds + (bufoff) + ldsw + _i * 8192), 16, 0, 0); } while (0)
#define PG8_LDA(dst, b, h) do { _Pragma("unroll") for (int m = 0; m < 4; ++m) _Pragma("unroll") for (int k = 0; k < 2; ++k) dst[m][k] = *(const LAS bf16x8*)(lds + PG8_SA(b, h) + aoff + m * 2048 + k * 1024); } while (0)
#define PG8_LDB(dst, b, h) do { _Pragma("unroll") for (int n = 0; n < 2; ++n) _Pragma("unroll") for (int k = 0; k < 2; ++k) dst[n][k] = *(const LAS bf16x8*)(lds + PG8_SB(b, h) + boff + n * 2048 + k * 1024); } while (0)
#define PG8_MMA(ai, bj, At, Bt) do { __builtin_amdgcn_s_setprio(1); _Pragma("unroll") for (int m = 0; m < 4; ++m) _Pragma("unroll") for (int n = 0; n < 2; ++n) _Pragma("unroll") for (int k = 0; k < 2; ++k) \
        acc[ai][bj][m][n] = __builtin_amdgcn_mfma_f32_16x16x32_bf16(Bt[n][k], At[m][k], acc[ai][bj][m][n], 0, 0, 0); __builtin_amdgcn_s_setprio(0); } while (0)
#define PG8_WAIT_V(n) asm volatile("s_waitcnt vmcnt(" #n ")" ::: "memory")
#define PG8_WAIT_L(n) asm volatile("s_waitcnt lgkmcnt(" #n ")" ::: "memory")
#define PG8_BAR __builtin_amdgcn_s_barrier()
#define PG8_SCHED __builtin_amdgcn_sched_barrier(0)
    Unit cur, nxt; int ui = 0;
    if (!S.next(0, cur)) return;
    f32x4 acc[2][2][4][2];
#pragma unroll
    for (int a = 0; a < 2; ++a)
#pragma unroll
        for (int b = 0; b < 2; ++b)
#pragma unroll
            for (int m = 0; m < 4; ++m)
#pragma unroll
                for (int n = 0; n < 2; ++n) acc[a][b][m][n] = (f32x4){0.f, 0.f, 0.f, 0.f};
    bf16x8 At[4][2], B0[2][2], B1[2][2];
    const size_t khalf = (size_t)K;
#define PG8_UNIT(u, pa, pb, ha, hb, nk) do { if ((u).mode == 2) { pa = (const char*)g.A + (size_t)(u).pm * tstepA; pb = (const char*)g.Bt + (size_t)(u).pn * hstepB; ha = khalf; hb = khalf; nk = nt >> 1; } \
        else { pa = (const char*)g.A + (size_t)(u).pm * tstepA + (size_t)(((u).pn / g.akdiv) * g.akmul) * 2; pb = (const char*)g.Bt + (size_t)(u).pn * tstepB; ha = hstepA; hb = hstepB; nk = nt; } } while (0)
    const char* cA; const char* cB; size_t chA, chB; int cnk;
    PG8_UNIT(cur, cA, cB, chA, chB, cnk);
    if constexpr (SP2) {
        PG8_STAGE(PG8_SB(0, 0), cB, voffB); PG8_STAGE(PG8_SB(0, 1), cB + chB, voffB); PG8_STAGE(PG8_SA(0, 0), cA, voffA); PG8_STAGE(PG8_SA(0, 1), cA + chA, voffA);
        if (wr == 1) PG8_BAR;
        PG8_WAIT_V(2); PG8_BAR;
        PG8_STAGE(PG8_SB(1, 0), cB + kstep, voffB); PG8_STAGE(PG8_SA(1, 0), cA + kstep, voffA); PG8_STAGE(PG8_SB(1, 1), cB + chB + kstep, voffB);
        PG8_WAIT_V(6); PG8_BAR;
    }
    for (;;) {
        const bool has_next = S.next(ui + 1, nxt);
        const int mode = cur.mode;
        const char* nA = cA; const char* nB = cB; size_t nhA = chA, nhB = chB; int nnk = cnk;
        if (has_next) PG8_UNIT(nxt, nA, nB, nhA, nhB, nnk);
        for (int t = 0; t < cnk; t += 2) {
            const bool last = (t == cnk - 2);
            const char* a1 = cA + (size_t)(t + 1) * kstep;
            const char* a2 = last ? nA : cA + (size_t)(t + 2) * kstep; const char* b2 = last ? nB : cB + (size_t)(t + 2) * kstep;
            const size_t hA2 = last ? nhA : chA, hB2 = last ? nhB : chB;
            const char* a3 = a2 + kstep; const char* b3 = b2 + kstep;
            PG8_LDB(B0, 0, 0); PG8_LDB(B1, 0, 1); PG8_SCHED; PG8_LDA(At, 0, 0); PG8_STAGE(PG8_SA(1, 1), a1 + chA, voffA);
            PG8_WAIT_V(8); PG8_WAIT_L(0); PG8_BAR; PG8_MMA(0, 0, At, B0); if (mode != 2) PG8_MMA(0, 1, At, B1); PG8_BAR; PG8_SCHED;
            if (mode != 1) PG8_LDA(At, 0, 1); PG8_STAGE(PG8_SB(0, 0), b2, voffB); PG8_STAGE(PG8_SB(0, 1), b2 + hB2, voffB); PG8_STAGE(PG8_SA(0, 0), a2, voffA);
            PG8_WAIT_V(8); PG8_WAIT_L(0); PG8_BAR; if (mode == 0) PG8_MMA(1, 0, At, B0); if (mode != 1) PG8_MMA(1, 1, At, B1); PG8_BAR; PG8_SCHED;
            PG8_LDB(B0, 1, 0); PG8_LDB(B1, 1, 1); PG8_SCHED; PG8_LDA(At, 1, 0); PG8_STAGE(PG8_SA(0, 1), a2 + hA2, voffA);
            PG8_WAIT_V(8); PG8_WAIT_L(0); PG8_BAR; PG8_MMA(0, 0, At, B0); if (mode != 2) PG8_MMA(0, 1, At, B1); PG8_BAR; PG8_SCHED;
            if (mode != 1) PG8_LDA(At, 1, 1); PG8_STAGE(PG8_SB(1, 0), b3, voffB); PG8_STAGE(PG8_SB(1, 1), b3 + hB2, voffB); PG8_STAGE(PG8_SA(1, 0), a3, voffA);
            PG8_WAIT_V(8); PG8_WAIT_L(0); PG8_BAR; if (mode == 0) PG8_MMA(1, 0, At, B0); if (mode != 1) PG8_MMA(1, 1, At, B1); PG8_BAR; PG8_SCHED;
        }
        if constexpr (ALIGN_EPI) { if (wr == 0) PG8_BAR; }
        if (mode == 2) {
#pragma unroll
            for (int m = 0; m < 4; ++m)
#pragma unroll
                for (int n = 0; n < 2; ++n) acc[0][0][m][n] += acc[1][1][m][n]; }
        { int fr_ = fr, fq_ = fq; asm volatile("" : "+v"(fr_), "+v"(fq_));
          E(acc, cur, wr, wc, fr_, fq_); }
        if (!has_next) break;
#pragma unroll
        for (int a = 0; a < 2; ++a)
#pragma unroll
            for (int b = 0; b < 2; ++b)
#pragma unroll
                for (int m = 0; m < 4; ++m)
#pragma unroll
                    for (int n = 0; n < 2; ++n) acc[a][b][m][n] = (f32x4){0.f, 0.f, 0.f, 0.f};
        cur = nxt; cA = nA; cB = nB; chA = nhA; chB = nhB; cnk = nnk; ++ui;
        if constexpr (ALIGN_EPI) { if (wr == 1) PG8_BAR; }
    }
#undef PG8_UNIT
    PG8_WAIT_V(0);
    if constexpr (!ALIGN_EPI) { if (wr == 0) PG8_BAR; }
    PG8_BAR;
#undef PG8_SA
#undef PG8_SB
#undef PG8_STAGE
#undef PG8_LDA
#undef PG8_LDB
#undef PG8_MMA
#undef PG8_WAIT_V
#undef PG8_WAIT_L
#undef PG8_BAR
#undef PG8_SCHED
}
}

enum { SK_BF16 = 0, SK_RESID_F32, SK_RESID_INPLACE, SK_GATEUP, SK_PLE };
struct SkArgs { const bf16_t* A; int lda; const bf16_t* Bt; int ldb; int K, N; bf16_t* out; int ldo; const float* xs; float* ssout; const float* ssin; const bf16_t* x2b; const bf16_t* pp; };
template <int KIND, int MH, int NT, int D>
__device__ __forceinline__ void skinny_phase(LAS unsigned char* lds, const SkArgs s, int G) {
    constexpr int RT = 8 / MH, RM = 128 / MH, LD = 16 * NT + 4;
    static_assert(MH == 1 || NT == 1, "column batching only with full rows");
    const int tid = threadIdx.x, lane = tid & 63, wave = __builtin_amdgcn_readfirstlane(tid >> 6), c16 = lane & 15, g = lane >> 4;
    const int T = s.N / 16, I = T * MH, c = (int)blockIdx.x;
    const int i_lo = (int)((long)c * I / G), i_hi = (int)((long)(c + 1) * I / G);
    const int kw = s.K / 8, kb = wave * kw, nsteps = kw / 32;
    LAS float* part = (LAS float*)lds;
    for (int it0 = i_lo; it0 < i_hi; it0 += NT) {
        const int nct = (i_hi - it0) < NT ? (i_hi - it0) : NT, ct0 = it0 / MH, rh = it0 % MH;
        f32x4 acc[RT][NT];
#pragma unroll
        for (int rt = 0; rt < RT; ++rt)
#pragma unroll
            for (int j = 0; j < NT; ++j) acc[rt][j] = (f32x4){0.f, 0.f, 0.f, 0.f};
        const bf16_t* pa = s.A + (size_t)(RM * rh + c16) * s.lda + kb + 8 * g;
        const bf16_t* pb[NT];
#pragma unroll
        for (int j = 0; j < NT; ++j) pb[j] = s.Bt + (size_t)(16 * (ct0 + (j < nct ? j : 0)) + c16) * s.ldb + kb + 8 * g;
        const size_t rstep = (size_t)16 * s.lda;
        bf16x8 ar[D][RT], br[D][NT];
#define SK_LOAD(d, st) do { _Pragma("unroll") for (int rt = 0; rt < RT; ++rt) ar[d][rt] = *(const bf16x8*)(pa + rt * rstep + 32 * (st)); \
        _Pragma("unroll") for (int j = 0; j < NT; ++j) br[d][j] = *(const bf16x8*)(pb[j] + 32 * (st)); } while (0)
#define SK_MMA(d) do { _Pragma("unroll") for (int rt = 0; rt < RT; ++rt) _Pragma("unroll") for (int j = 0; j < NT; ++j) acc[rt][j] = __builtin_amdgcn_mfma_f32_16x16x32_bf16(ar[d][rt], br[d][j], acc[rt][j], 0, 0, 0); } while (0)
#pragma unroll
        for (int d = 0; d < D; ++d) if (d < nsteps) SK_LOAD(d, d);
#pragma unroll 1
        for (int st = 0; st < nsteps; st += D) {
#pragma unroll
            for (int d = 0; d < D; ++d) if (st + d < nsteps) { SK_MMA(d); if (st + d + D < nsteps) SK_LOAD(d, st + d + D); } }
#undef SK_LOAD
#undef SK_MMA
#pragma unroll
        for (int h = 0; h < RM / 64; ++h) {
#pragma unroll
            for (int rq = 0; rq < 4; ++rq)
#pragma unroll
                for (int j = 0; j < NT; ++j)
#pragma unroll
                    for (int r = 0; r < 4; ++r) part[(wave * 64 + 16 * rq + 4 * g + r) * LD + 16 * j + c16] = acc[4 * h + rq][j][r];
            __syncthreads();
            { const int row = tid >> 3, cg = tid & 7, R = RM * rh + 64 * h + row; const size_t m = (size_t)MPROMPT + R;
              const int la = KIND == SK_GATEUP ? 8 * (cg >> 2) + (cg & 3) : 2 * cg, lb = KIND == SK_GATEUP ? la + 4 : la + 1;
              float q = 0.f, rs = 0.f;
              if (KIND == SK_GATEUP || KIND == SK_PLE) rs = rsqrtf(s.ssin[m] * (1.f / DM) + EPS);
              for (int j = 0; j < nct; ++j) { float vA = 0.f, vB = 0.f;
#pragma unroll
                  for (int w = 0; w < 8; ++w) { vA += part[(w * 64 + row) * LD + 16 * j + la]; vB += part[(w * 64 + row) * LD + 16 * j + lb]; }
                  const int col = 16 * (ct0 + j) + la;
                  if (KIND == SK_BF16) { *(unsigned*)(s.out + m * s.ldo + col) = pk2(vA, vB); }
                  else if (KIND == SK_RESID_F32) { const f32x2 xo = *(const f32x2*)(s.xs + (size_t)R * DM + col); vA += xo.x; vB += xo.y; *(unsigned*)(s.out + m * DM + col) = pk2(vA, vB); q += vA * vA + vB * vB; }
                  else if (KIND == SK_RESID_INPLACE) { const unsigned wo = *(const unsigned*)(s.out + m * DM + col); vA += bflo(wo); vB += bfhi(wo); *(unsigned*)(s.out + m * DM + col) = pk2(vA, vB); q += vA * vA + vB * vB; }
                  else if (KIND == SK_GATEUP) { const float gg = vA * rs, uu = vB * rs; s.out[m * s.ldo + 8 * (ct0 + j) + cg] = (bf16_t)f2bf(gg * sigmoidf_(gg) * uu); }
                  else { const unsigned xw = *(const unsigned*)(s.x2b + m * DM + col), pw = *(const unsigned*)(s.pp + m * DM + col);
                      vA = bflo(xw) + sigmoidf_(vA * rs) * bflo(pw); vB = bfhi(xw) + sigmoidf_(vB * rs) * bfhi(pw); *(unsigned*)(s.out + m * DM + col) = pk2(vA, vB); q += vA * vA + vB * vB; } }
              if (KIND == SK_RESID_F32 || KIND == SK_RESID_INPLACE || KIND == SK_PLE) { q = row8_sum(q); if (cg == 0) atomicAdd(s.ssout + m, q); } }
            __syncthreads();
        }
    }
}

struct Args { const float* in[31]; float* out; unsigned char* ws; int ph_lo, ph_hi; };
enum { I_XP = 0, I_XS, I_SWKV, I_SSHIFT, I_CK, I_CV, I_PP, I_PS, I_NMIX, I_WIN, I_MU, I_W0, I_W2, I_A0, I_A2, I_G2, I_KK, I_KA, I_RK, I_LNW, I_LNB, I_SINK, I_WOUT, I_NFFN, I_WGATE, I_WUP, I_WDOWN, I_NPLE, I_PGATE, I_PPROJ, I_FNORM };

__device__ __forceinline__ void tr_item(const float* W, int K, int N, bf16_t* WT, const float* gain, int mode, LAS unsigned char* scr, int item, int lane) {
    const int nblk = N / 64, kb = item / nblk, nb = item % nblk, k0 = 64 * kb, n0 = 64 * nb, r = lane >> 4, c4 = (lane & 15) * 4;
    const float* src = W + (size_t)(k0 + 16 * r) * N + n0 + c4;
    f32x4 v[16];
#pragma unroll
    for (int i = 0; i < 16; ++i) v[i] = *(const f32x4*)(src + (size_t)i * N);
    if (gain) {
#pragma unroll
        for (int i = 0; i < 16; ++i) v[i] = v[i] * gain[k0 + 16 * r + i]; }
#pragma unroll
    for (int jj = 0; jj < 4; ++jj) { u32x4 lo, hi;
        lo.x = cvt_pk_bf16(v[0][jj], v[1][jj]); lo.y = cvt_pk_bf16(v[2][jj], v[3][jj]); lo.z = cvt_pk_bf16(v[4][jj], v[5][jj]); lo.w = cvt_pk_bf16(v[6][jj], v[7][jj]);
        hi.x = cvt_pk_bf16(v[8][jj], v[9][jj]); hi.y = cvt_pk_bf16(v[10][jj], v[11][jj]); hi.z = cvt_pk_bf16(v[12][jj], v[13][jj]); hi.w = cvt_pk_bf16(v[14][jj], v[15][jj]);
        *(LAS u32x4*)(scr + (c4 + jj) * 144 + 32 * r) = lo; *(LAS u32x4*)(scr + (c4 + jj) * 144 + 32 * r + 16) = hi; }
    LDS_WAIT(); asm volatile("" ::: "memory");
#pragma unroll
    for (int q = 0; q < 8; ++q) { const int n = (lane >> 3) + 8 * q, ch = lane & 7, nn = n0 + n; const u32x4 o = *(const LAS u32x4*)(scr + n * 144 + ch * 16);
        const int row = mode == 0 ? nn : (2 * nn - (nn & 3) + (mode == 2 ? 4 : 0));
        *(u32x4*)(WT + (size_t)row * K + k0 + 8 * ch) = o; }
    LDS_WAIT(); asm volatile("" ::: "memory");
}
__device__ __forceinline__ void convert_jobs(const Args& a, LAS unsigned char* lds, int j0, int j1, int w, int nw) {
    const int lane = threadIdx.x & 63, wave = __builtin_amdgcn_readfirstlane(threadIdx.x >> 6);
    LAS unsigned char* scr = lds + wave * 16384; unsigned char* ws = a.ws;
    for (int j = j0; j < j1; ++j) {
        const float* W; int K, N, mode = 0; bf16_t* WT; const float* gain = nullptr;
        switch (j) {
            case 0: W = a.in[I_WIN]; K = DM; N = PROJ; WT = (bf16_t*)(ws + WS_WIN); break;
            case 1: W = a.in[I_WOUT]; K = DM; N = DM; WT = (bf16_t*)(ws + WS_WOUT); break;
            case 2: W = a.in[I_WGATE]; K = DM; N = DFF; WT = (bf16_t*)(ws + WS_WGU); gain = a.in[I_NFFN]; mode = 1; break;
            case 3: W = a.in[I_WUP]; K = DM; N = DFF; WT = (bf16_t*)(ws + WS_WGU); gain = a.in[I_NFFN]; mode = 2; break;
            case 4: W = a.in[I_WDOWN]; K = DFF; N = DM; WT = (bf16_t*)(ws + WS_WD); break;
            case 5: W = a.in[I_PGATE]; K = DM; N = DM; WT = (bf16_t*)(ws + WS_WPG); gain = a.in[I_NPLE]; break;
            default: W = a.in[I_PPROJ]; K = PLE; N = DM; WT = (bf16_t*)(ws + WS_WPP); break;
        }
        const int nitems = (K / 64) * (N / 64);
        for (int it = w; it < nitems; it += nw) tr_item(W, K, N, WT, gain, mode, scr, it, lane);
    }
}
__device__ __forceinline__ void tail_convert(const Args& a, LAS unsigned char* lds, int nwg, int G, int j0, int j1) {
    const int rem = nwg % G, c = (int)blockIdx.x, wave = __builtin_amdgcn_readfirstlane(threadIdx.x >> 6);
    if (rem == 0) { convert_jobs(a, lds, j0, j1, c * 8 + wave, G * 8); return; }
    if (c >= rem) convert_jobs(a, lds, j0, j1, (c - rem) * 8 + wave, (G - rem) * 8);
}
__device__ __forceinline__ void p0_prologue(const Args& a, LAS unsigned char* lds, int G) {
    const int tid = threadIdx.x, lane = tid & 63, wave = __builtin_amdgcn_readfirstlane(tid >> 6);
    const int gw = blockIdx.x * 8 + wave, NGW = G * 8;
    unsigned char* ws = a.ws;
    convert_jobs(a, lds, 0, 1, gw, NGW);
    const int gt = blockIdx.x * 512 + tid, NGT = G * 512;
    { u32x4* zp = (u32x4*)((bf16_t*)(ws + WS_WIN) + (size_t)PROJ * DM); for (int i = gt; i < (ZP - PROJ) * DM / 8; i += NGT) zp[i] = (u32x4){0u, 0u, 0u, 0u}; }
    { bf16_t* wl = (bf16_t*)(ws + WS_WLORA);
      for (int i = gt; i < 3 * 256 * 1024; i += NGT) { const int which = i / (256 * 1024), rem = i % (256 * 1024), k = rem / 1024, n = rem % 1024;
          const int kw = which == 2 ? 256 : 96; const float* W = which == 0 ? a.in[I_W2] : (which == 1 ? a.in[I_A2] : a.in[I_G2]);
          const float v = k < kw ? W[(size_t)k * 1024 + n] : 0.f; wl[((size_t)which * 1024 + n) * 256 + k] = (bf16_t)f2bf(v); } }
    { float* s1 = (float*)(ws + WS_SS1); float* s2 = (float*)(ws + WS_SS2); float* s3 = (float*)(ws + WS_SS3); for (int i = gt; i < MP; i += NGT) { s1[i] = 0.f; s2[i] = 0.f; s3[i] = 0.f; } }
    { bf16_t* hb = (bf16_t*)(ws + WS_HB); const float* gmix = a.in[I_NMIX];
      for (int m = gw; m < MP; m += NGW) {
          u32x2* o = (u32x2*)(hb + (size_t)m * DM) + lane;
          if (m >= MTOK) { for (int j = 0; j < 8; ++j) o[64 * j] = (u32x2){0u, 0u}; continue; }
          const f32x4* xr = (const f32x4*)(m < MPROMPT ? a.in[I_XP] + (size_t)m * DM : a.in[I_XS] + (size_t)(m - MPROMPT) * DM) + lane;
          f32x4 v[8]; float s = 0.f;
#pragma unroll
          for (int j = 0; j < 8; ++j) { v[j] = xr[64 * j]; s += (v[j].x * v[j].x + v[j].y * v[j].y) + (v[j].z * v[j].z + v[j].w * v[j].w); }
          const float rs = rsqrtf(wave_sum(s) * (1.f / DM) + EPS);
#pragma unroll
          for (int j = 0; j < 8; ++j) { const f32x4 gg = ((const f32x4*)gmix)[lane + 64 * j]; u32x2 w; w.x = pk2(v[j].x * rs * gg.x, v[j].y * rs * gg.y); w.y = pk2(v[j].z * rs * gg.z, v[j].w * rs * gg.w); o[64 * j] = w; }
      } }
}

__device__ __forceinline__ void p2_lora_prep(const Args& a, int G) {
    const int tid = threadIdx.x, lane = tid & 63, wave = tid >> 6, gw = blockIdx.x * 8 + wave, NGW = G * 8;
    const bf16_t* z = (const bf16_t*)(a.ws + WS_Z); bf16_t* al = (bf16_t*)(a.ws + WS_MIX); const float* mu = a.in[I_MU]; const float* sshift = a.in[I_SSHIFT]; float* kn = (float*)(a.ws + WS_RKR);
    for (int m = gw; m < MP; m += NGW) {
        bf16_t* orow = al + (size_t)m * 768;
        const bool live = m < MTOK;
        const bool has_prev = m < MPROMPT && (m % SEQ) != 0;
#pragma unroll
        for (int pass = 0; pass < 2; ++pass) { const int gidx = lane + 64 * pass;
            if (gidx < 112) { const int zc = ZXW + 4 * gidx; const int seg = gidx < 24 ? 0 : (gidx < 48 ? 1 : 2); const int oc = seg == 0 ? 4 * gidx : (seg == 1 ? 256 + 4 * (gidx - 24) : 512 + 4 * (gidx - 48));
                f32x4 o = {0.f, 0.f, 0.f, 0.f};
                if (live) { const u32x2 zw = *(const u32x2*)(z + (size_t)m * ZP + zc); const f32x4 cur = {bflo(zw.x), bfhi(zw.x), bflo(zw.y), bfhi(zw.y)}; f32x4 prev = {0.f, 0.f, 0.f, 0.f};
                    if (has_prev) { const u32x2 pw = *(const u32x2*)(z + (size_t)(m - 1) * ZP + zc); prev = (f32x4){bflo(pw.x), bfhi(pw.x), bflo(pw.y), bfhi(pw.y)}; }
                    else if (m >= MPROMPT) prev = *(const f32x4*)(sshift + (size_t)(m - MPROMPT) * RWKV_PROJ + zc);
                    const f32x4 xs = cur + (prev - cur) * *(const f32x4*)(mu + zc);
#pragma unroll
                    for (int e = 0; e < 4; ++e) { if (seg == 0) { const float t = __expf(2.f * xs[e]); o[e] = 1.f - 2.f * __builtin_amdgcn_rcpf(t + 1.f); } else if (seg == 1) o[e] = xs[e]; else o[e] = sigmoidf_(xs[e]); } }
                u32x2 w; w.x = pk2(o[0], o[1]); w.y = pk2(o[2], o[3]); *(u32x2*)(orow + oc) = w; } }
        if (lane < 40) { const int oc = lane < 20 ? 96 + 8 * lane : 352 + 8 * (lane - 20); *(u32x4*)(orow + oc) = (u32x4){0u, 0u, 0u, 0u}; }
        if (live) {
#pragma unroll
        for (int hg = 0; hg < 4; ++hg) { const int head = hg * 4 + (lane >> 4), j = head * 64 + (lane & 15) * 4;
            const u32x2 zc = *(const u32x2*)(z + (size_t)m * ZP + 1024 + j); const f32x4 kc = {bflo(zc.x), bfhi(zc.x), bflo(zc.y), bfhi(zc.y)};
            f32x4 pk = {0.f, 0.f, 0.f, 0.f};
            if (has_prev) { const u32x2 zp = *(const u32x2*)(z + (size_t)(m - 1) * ZP + 1024 + j); pk = (f32x4){bflo(zp.x), bfhi(zp.x), bflo(zp.y), bfhi(zp.y)}; }
            else if (m >= MPROMPT) pk = *(const f32x4*)(sshift + (size_t)(m - MPROMPT) * RWKV_PROJ + 1024 + j);
            const f32x4 k = (kc + (pk - kc) * *(const f32x4*)(mu + 1024 + j)) * *(const f32x4*)(a.in[I_KK] + j);
            const float ss = row16_sum((k[0] * k[0] + k[1] * k[1]) + (k[2] * k[2] + k[3] * k[3]));
            if ((lane & 15) == 0) kn[(size_t)m * 16 + head] = rsqrtf(fmaxf(ss, 1e-24f)); } }
    }
}

constexpr int AL_STRIDE = 912;
template <int P> __device__ __forceinline__ void lora_epi(const Args& a, const f32x4 (&acc)[4][4], size_t m0, int ntile0, int c16, int kq) {
    bf16_t* out = (bf16_t*)(a.ws + WS_LORA);
#pragma unroll
    for (int i = 0; i < 4; ++i) { const int n0 = (ntile0 + i) * 16 + 4 * kq;
#pragma unroll
        for (int tt = 0; tt < 4; ++tt) { f32x4 v = acc[i][tt];
            if (P < 2) {
#pragma unroll
                for (int e = 0; e < 4; ++e) v[e] = (P == 0 ? 0.60653066f : 1.f) * sigmoidf_(v[e]); }
            u32x2 w; w.x = pk2(v[0], v[1]); w.y = pk2(v[2], v[3]);
            *(u32x2*)(out + (m0 + tt * 16 + c16) * 3072 + P * 1024 + n0) = w; } }
}
constexpr int LORA_D = 4, LORA_BIAS_OFF = 64 * AL_STRIDE;
__host__ __device__ constexpr int lora_step_p(int s) { return (s % 14) < 3 ? 0 : ((s % 14) < 6 ? 1 : 2); }
__host__ __device__ constexpr int lora_step_ks(int s) { return (s % 14) < 3 ? (s % 14) : ((s % 14) < 6 ? (s % 14) - 3 : (s % 14) - 6); }
typedef int i32x4_t __attribute__((ext_vector_type(4)));
template <int S> __device__ __forceinline__ void lora_load_step(bf16x8 (&ring)[LORA_D][4], const bf16_t* wbase) {
    const __amdgpu_buffer_rsrc_t wres = __builtin_amdgcn_make_buffer_rsrc((void*)wbase, 0, 0x7fffffff, 0x00020000);
    constexpr int off = ((lora_step_p(S) * 1024 + (S / 14) * 64) * 256 + 32 * lora_step_ks(S)) * 2;
    const int lane = (int)(threadIdx.x & 63), wave = __builtin_amdgcn_readfirstlane((int)(threadIdx.x >> 6));
    const int voff = ((lane & 15) * 256 + 8 * (lane >> 4)) * 2, soff = wave * (128 * 256 * 2) + off;
#pragma unroll
    for (int i = 0; i < 4; ++i) ring[S % LORA_D][i] = __builtin_bit_cast(bf16x8, __builtin_amdgcn_raw_buffer_load_b128(wres, voff, soff + i * 8192, 0));
}
template <int S> struct LoraSteps {
    static __device__ __forceinline__ void run(const Args& a, const LAS unsigned char* albase, const bf16_t* wbase, bf16x8 (&ring)[LORA_D][4], f32x4 (&acc)[4][4], size_t m0, int wave, int c16, int kq) {
        constexpr int P = lora_step_p(S), ks = lora_step_ks(S), kcol = (P == 0 ? 0 : (P == 1 ? 96 : 192)) + 32 * ks;
        if constexpr (ks == 0) {
#pragma unroll
            for (int i = 0; i < 4; ++i) { f32x4 b0 = {0.f, 0.f, 0.f, 0.f};
                if constexpr (P < 2) b0 = *(const LAS f32x4*)(albase - (c16 * AL_STRIDE + 16 * kq) + LORA_BIAS_OFF + (P * 1024 + (wave * 8 + (S / 14) * 4 + i) * 16 + 4 * kq) * 4);
#pragma unroll
                for (int tt = 0; tt < 4; ++tt) { acc[i][tt] = b0; asm volatile("" : "+v"(acc[i][tt])); } } }
#pragma unroll
        for (int tt = 0; tt < 4; ++tt) { const bf16x8 av = *(const LAS bf16x8*)(albase + tt * 16 * AL_STRIDE + kcol * 2);
#pragma unroll
            for (int i = 0; i < 4; ++i) acc[i][tt] = __builtin_amdgcn_mfma_f32_16x16x32_bf16(ring[S % LORA_D][i], av, acc[i][tt], 0, 0, 0); }
        if constexpr (S + LORA_D < 28) lora_load_step<S + LORA_D>(ring, wbase);
        const int nt0 = wave * 8 + (S / 14) * 4;
        if constexpr (S % 14 == 2) lora_epi<0>(a, acc, m0, nt0, c16, kq);
        if constexpr (S % 14 == 5) lora_epi<1>(a, acc, m0, nt0, c16, kq);
        if constexpr (S % 14 == 13) lora_epi<2>(a, acc, m0, nt0, c16, kq);
        if constexpr (S + 1 < 28) LoraSteps<S + 1>::run(a, albase, wbase, ring, acc, m0, wave, c16, kq);
    }
};
__device__ __forceinline__ void lora_mfma_unit(const Args& a, LAS unsigned char* lds, size_t m0, int lane) {
    const int wave = __builtin_amdgcn_readfirstlane(threadIdx.x >> 6), c16 = lane & 15, kq = lane >> 4;
    const bf16_t* wbase = (const bf16_t*)(a.ws + WS_WLORA);
    const LAS unsigned char* albase = lds + c16 * AL_STRIDE + 16 * kq;
    bf16x8 ring[LORA_D][4];
    f32x4 acc[4][4];
    lora_load_step<0>(ring, wbase); lora_load_step<1>(ring, wbase); lora_load_step<2>(ring, wbase); lora_load_step<3>(ring, wbase);
    LoraSteps<0>::run(a, albase, wbase, ring, acc, m0, wave, c16, kq);
}
template <int P> __device__ __forceinline__ void lora_sample_tile(const Args& a, LAS unsigned char* lds, size_t m0, int ntile) {
    constexpr int NKS = P == 2 ? 8 : 3, KCOL0 = P == 0 ? 0 : (P == 1 ? 96 : 192);
    const int lane = threadIdx.x & 63, c16 = lane & 15, kq = lane >> 4;
    const bf16_t* wl = (const bf16_t*)(a.ws + WS_WLORA) + ((size_t)P * 1024 + ntile * 16 + c16) * 256 + 8 * kq;
    bf16x8 b[NKS];
#pragma unroll
    for (int ks = 0; ks < NKS; ++ks) b[ks] = *(const bf16x8*)(wl + 32 * ks);
    f32x4 acc = {0.f, 0.f, 0.f, 0.f}; asm volatile("" : "+v"(acc));
#pragma unroll
    for (int ks = 0; ks < NKS; ++ks) { const bf16x8 av = *(const LAS bf16x8*)(lds + c16 * AL_STRIDE + (KCOL0 + 32 * ks + 8 * kq) * 2); acc = __builtin_amdgcn_mfma_f32_16x16x32_bf16(b[ks], av, acc, 0, 0, 0); }
    const int n0 = ntile * 16 + 4 * kq;
    f32x4 bias = {0.f, 0.f, 0.f, 0.f}; if (P == 0) bias = *(const f32x4*)(a.in[I_W0] + n0); if (P == 1) bias = *(const f32x4*)(a.in[I_A0] + n0);
    f32x4 v = acc + bias;
    if (P < 2) {
#pragma unroll
        for (int e = 0; e < 4; ++e) v[e] = (P == 0 ? 0.60653066f : 1.f) * sigmoidf_(v[e]); }
    u32x2 w; w.x = pk2(v[0], v[1]); w.y = pk2(v[2], v[3]);
    *(u32x2*)((bf16_t*)(a.ws + WS_LORA) + (m0 + c16) * 3072 + P * 1024 + n0) = w;
}
template <int NTW> __device__ __forceinline__ void knorm_tokens(const Args& a, size_t m, int lane) {
    const bf16_t* z = (const bf16_t*)(a.ws + WS_Z); const float* mu = a.in[I_MU]; const float* sshift = a.in[I_SSHIFT]; float* kn = (float*)(a.ws + WS_RKR);
    u32x2 zk[NTW + 1][4];
#pragma unroll
    for (int hg = 0; hg < 4; ++hg) { const int j = (hg * 4 + (lane >> 4)) * 64 + (lane & 15) * 4;
        zk[0][hg] = (u32x2){0u, 0u}; if (m < MPROMPT && (m % SEQ) != 0) zk[0][hg] = *(const u32x2*)(z + (m - 1) * ZP + 1024 + j);
#pragma unroll
        for (int t = 0; t < NTW; ++t) zk[t + 1][hg] = *(const u32x2*)(z + (m + t) * ZP + 1024 + j); }
#pragma unroll
    for (int hg = 0; hg < 4; ++hg) { const int head = hg * 4 + (lane >> 4), j = head * 64 + (lane & 15) * 4;
        const f32x4 muk = *(const f32x4*)(mu + 1024 + j), kkc = *(const f32x4*)(a.in[I_KK] + j);
#pragma unroll
        for (int t = 0; t < NTW; ++t) { const f32x4 kc = bf4(zk[t + 1][hg]);
            f32x4 pk = bf4(zk[t][hg]); if (m + t >= MPROMPT) pk = *(const f32x4*)(sshift + (m + t - MPROMPT) * RWKV_PROJ + 1024 + j);
            const f32x4 k = (kc + (pk - kc) * muk) * kkc;
            const float ss = row16_sum((k[0] * k[0] + k[1] * k[1]) + (k[2] * k[2] + k[3] * k[3]));
            if ((lane & 15) == 0) kn[(m + t) * 16 + head] = rsqrtf(fmaxf(ss, 1e-24f)); } }
}
__device__ __forceinline__ void p2_lora_fused(const Args& a, LAS unsigned char* lds, int G) {
    const int tid = threadIdx.x, lane = tid & 63, wave = __builtin_amdgcn_readfirstlane(tid >> 6);
    const bf16_t* z = (const bf16_t*)(a.ws + WS_Z); const float* mu = a.in[I_MU]; const float* sshift = a.in[I_SSHIFT];
    { const f32x4 bv = tid < 256 ? ((const f32x4*)a.in[I_W0])[tid] : ((const f32x4*)a.in[I_A0])[tid - 256]; *(LAS f32x4*)(lds + LORA_BIAS_OFF + tid * 16) = bv; }
    for (int u = blockIdx.x; u < 512; u += G) {
        const bool single = u >= 256;
        const size_t m0 = single ? (size_t)MPROMPT + 16 * ((u - 256) >> 5) : (size_t)64 * u; const int ntok = single ? 16 : 64;
        { int g8 = tid & 7; asm volatile("" : "+v"(g8));
          const int t = tid >> 3; const size_t m = m0 + t; const bool act = t < ntok;
          const bool from_state = m >= MPROMPT, from_prev = !from_state && (m % SEQ) != 0;
#pragma unroll
          for (int jh = 0; jh < 2; ++jh) { asm volatile("" ::: "memory");
          u32x2 zc_[7], zp_[7]; f32x4 sp_[7];
#pragma unroll
          for (int jj = 0; jj < 7; ++jj) { const int zc = ZXW + 4 * (g8 + 8 * (jh * 7 + jj)); zc_[jj] = (u32x2){0u, 0u}; zp_[jj] = (u32x2){0u, 0u}; sp_[jj] = (f32x4){0.f, 0.f, 0.f, 0.f};
              if (act) { zc_[jj] = *(const u32x2*)(z + m * ZP + zc); if (from_prev) zp_[jj] = *(const u32x2*)(z + (m - 1) * ZP + zc); if (from_state) sp_[jj] = *(const f32x4*)(sshift + (m - MPROMPT) * RWKV_PROJ + zc); } }
          if (act) {
#pragma unroll
          for (int jj = 0; jj < 7; ++jj) { const int gi = g8 + 8 * (jh * 7 + jj), zc = ZXW + 4 * gi;
              const f32x4 cur = bf4(zc_[jj]);
              const f32x4 prev = from_state ? sp_[jj] : bf4(zp_[jj]);
              const f32x4 xs = cur + (prev - cur) * *(const f32x4*)(mu + zc);
              f32x4 o;
#pragma unroll
              for (int e = 0; e < 4; ++e) { const int jg = jh * 7 + jj;
                  if (jg < 3) { const float tq = __expf(2.f * xs[e]); o[e] = 1.f - 2.f * __builtin_amdgcn_rcpf(tq + 1.f); } else if (jg < 6) o[e] = xs[e]; else o[e] = sigmoidf_(xs[e]); }
              u32x2 w; w.x = pk2(o[0], o[1]); w.y = pk2(o[2], o[3]); *(LAS u32x2*)(lds + t * AL_STRIDE + gi * 8) = w; } } } }
        int lane_ = lane; asm volatile("" : "+v"(lane_));
        if (!single) knorm_tokens<8>(a, m0 + 8 * wave, lane_); else if (((u - 256) & 31) == 0) knorm_tokens<2>(a, m0 + 2 * wave, lane_);
        __syncthreads();
        if (!single) lora_mfma_unit(a, lds, m0, lane_);
        else { const int ns = (u - 256) & 31, nt = 2 * ns + (wave & 1);
            if (wave < 2) lora_sample_tile<0>(a, lds, m0, nt); else if (wave < 4) lora_sample_tile<1>(a, lds, m0, nt); else if (wave < 6) lora_sample_tile<2>(a, lds, m0, nt); }
        __syncthreads();
    }
}

constexpr int TC = 32;
constexpr int OP_TOK = 6 * 64;
struct RwkvConst { float mu_r, mu_k, mu_v, kkc, kac; };
__device__ __forceinline__ void rwkv_prep_token(LAS float* op, int lane, const RwkvConst& c, float zr, float zk, float zv, float pr, float pk, float pv, float e, float av, float kn) {
    const float r = zr + (pr - zr) * c.mu_r, k = zk + (pk - zk) * c.mu_k, v = zv + (pv - zv) * c.mu_v;
    const float d = __builtin_amdgcn_exp2f(-1.44269504f * e);
    const float kk = k * c.kkc * kn;
    const float kh = k * (1.f + (av - 1.f) * c.kac);
    op[lane] = kk; op[64 + lane] = d; op[128 + lane] = -kk * av; op[192 + lane] = kh; op[256 + lane] = r; op[320 + lane] = v;
}
__device__ __forceinline__ RwkvConst rwkv_consts(const Args& a, int h, int lane) {
    const int j = h * 64 + lane; RwkvConst c;
    c.mu_r = a.in[I_MU][j]; c.mu_k = a.in[I_MU][1024 + j]; c.mu_v = a.in[I_MU][2048 + j]; c.kkc = a.in[I_KK][j]; c.kac = a.in[I_KA][j];
    return c;
}
struct StepOps { f32x4 kk, d, nb, kh, r; float vv; };
__device__ __forceinline__ StepOps rwkv_load_ops(const LAS float* op, int k0, int vrow) {
    StepOps o; o.kk = *(const LAS f32x4*)(op + k0); o.d = *(const LAS f32x4*)(op + 64 + k0); o.nb = *(const LAS f32x4*)(op + 128 + k0); o.kh = *(const LAS f32x4*)(op + 192 + k0); o.r = *(const LAS f32x4*)(op + 256 + k0); o.vv = op[320 + vrow]; return o;
}
__device__ __forceinline__ float rwkv_step_ops(f32x2& s01, f32x2& s23, const StepOps& o) {
    f32x2 t = s01 * o.kk.lo; t = __builtin_elementwise_fma(s23, o.kk.hi, t);
    const float dot = row16_sum(t.x + t.y);
    const f32x2 dd = {dot, dot}, vv = {o.vv, o.vv};
    s01 = s01 * o.d.lo; s23 = s23 * o.d.hi;
    s01 = __builtin_elementwise_fma(dd, o.nb.lo, s01); s23 = __builtin_elementwise_fma(dd, o.nb.hi, s23);
    s01 = __builtin_elementwise_fma(vv, o.kh.lo, s01); s23 = __builtin_elementwise_fma(vv, o.kh.hi, s23);
    f32x2 u = s01 * o.r.lo; u = __builtin_elementwise_fma(s23, o.r.hi, u);
    return row16_sum(u.x + u.y);
}
struct StepOps8 { f32x4 kk0, kk1, d0, d1, nb0, nb1, kh0, kh1, r0, r1; float vv; };
__device__ __forceinline__ StepOps8 rwkv_load_ops8(const LAS float* op, int k0, int vrow) {
    StepOps8 o; o.kk0 = *(const LAS f32x4*)(op + k0); o.kk1 = *(const LAS f32x4*)(op + k0 + 4); o.d0 = *(const LAS f32x4*)(op + 64 + k0); o.d1 = *(const LAS f32x4*)(op + 64 + k0 + 4);
    o.nb0 = *(const LAS f32x4*)(op + 128 + k0); o.nb1 = *(const LAS f32x4*)(op + 128 + k0 + 4); o.kh0 = *(const LAS f32x4*)(op + 192 + k0); o.kh1 = *(const LAS f32x4*)(op + 192 + k0 + 4);
    o.r0 = *(const LAS f32x4*)(op + 256 + k0); o.r1 = *(const LAS f32x4*)(op + 256 + k0 + 4); o.vv = op[320 + vrow]; return o;
}
__device__ __forceinline__ float rwkv_step_ops8(f32x2 (&s)[4], const StepOps8& o) {
    f32x2 t0 = s[0] * o.kk0.lo, t1 = s[2] * o.kk1.lo; t0 = __builtin_elementwise_fma(s[1], o.kk0.hi, t0); t1 = __builtin_elementwise_fma(s[3], o.kk1.hi, t1); t0 = t0 + t1;
    const float dot = row8_sum(t0.x + t0.y);
    const f32x2 dd = {dot, dot}, vv = {o.vv, o.vv};
    s[0] = s[0] * o.d0.lo; s[1] = s[1] * o.d0.hi; s[2] = s[2] * o.d1.lo; s[3] = s[3] * o.d1.hi;
    s[0] = __builtin_elementwise_fma(dd, o.nb0.lo, s[0]); s[1] = __builtin_elementwise_fma(dd, o.nb0.hi, s[1]); s[2] = __builtin_elementwise_fma(dd, o.nb1.lo, s[2]); s[3] = __builtin_elementwise_fma(dd, o.nb1.hi, s[3]);
    s[0] = __builtin_elementwise_fma(vv, o.kh0.lo, s[0]); s[1] = __builtin_elementwise_fma(vv, o.kh0.hi, s[1]); s[2] = __builtin_elementwise_fma(vv, o.kh1.lo, s[2]); s[3] = __builtin_elementwise_fma(vv, o.kh1.hi, s[3]);
    f32x2 u0 = s[0] * o.r0.lo, u1 = s[2] * o.r1.lo; u0 = __builtin_elementwise_fma(s[1], o.r0.hi, u0); u1 = __builtin_elementwise_fma(s[3], o.r1.hi, u1); u0 = u0 + u1;
    return row8_sum(u0.x + u0.y);
}
__device__ __forceinline__ void scan_prompt_item(const Args& a, LAS unsigned char* lds, int item) {
    const int chain = item >> 1, half = item & 1, b = chain >> 4, h = chain & 15;
    const int tid = threadIdx.x, lane = tid & 63, wave = __builtin_amdgcn_readfirstlane(tid >> 6);
    LAS float* OP = (LAS float*)lds;
    LAS float* YB = (LAS float*)(lds + 2 * TC * OP_TOK * 4);
    const bf16_t* z = (const bf16_t*)(a.ws + WS_Z); const bf16_t* lo = (const bf16_t*)(a.ws + WS_LORA);
    float* ybuf = (float*)(a.ws + WS_HB); const float* knp = (const float*)(a.ws + WS_RKR);
    const size_t mrow0 = (size_t)b * SEQ;
    constexpr int NCH = SEQ / TC;
    const RwkvConst c = rwkv_consts(a, h, lane);
    const int j = h * 64 + lane;
    constexpr int TPW = TC / 4, TP0 = TC / 8;
    unsigned short zr_[TPW + 1], zk_[TPW + 1], zv_[TPW + 1], e_[TPW], a_[TPW]; float kn_[TPW];
    const __amdgpu_buffer_rsrc_t zres = __builtin_amdgcn_make_buffer_rsrc((void*)z, 0, 0x7fffffff, 0x00020000), lres = __builtin_amdgcn_make_buffer_rsrc((void*)lo, 0, 0x7fffffff, 0x00020000);
    const int jo = j * 2;
#define SCAN_LOAD(tfirst, NT) do { const int t0_ = __builtin_amdgcn_readfirstlane(tfirst); const int zo_ = (int)((mrow0 + t0_) * (ZP * 2)), lo_ = (int)((mrow0 + t0_) * (3072 * 2)); \
        _Pragma("unroll") for (int i_ = 0; i_ < (NT); ++i_) { \
            zr_[i_ + 1] = __builtin_amdgcn_raw_buffer_load_b16(zres, jo, zo_ + i_ * (ZP * 2), 0); zk_[i_ + 1] = __builtin_amdgcn_raw_buffer_load_b16(zres, jo + 2048, zo_ + i_ * (ZP * 2), 0); zv_[i_ + 1] = __builtin_amdgcn_raw_buffer_load_b16(zres, jo, zo_ + i_ * (ZP * 2) + 4096, 0); \
            e_[i_] = __builtin_amdgcn_raw_buffer_load_b16(lres, jo, lo_ + i_ * (3072 * 2), 0); a_[i_] = __builtin_amdgcn_raw_buffer_load_b16(lres, jo + 2048, lo_ + i_ * (3072 * 2), 0); kn_[i_] = knp[(mrow0 + t0_ + i_) * 16 + h]; } \
        if (t0_ > 0) { zr_[0] = __builtin_amdgcn_raw_buffer_load_b16(zres, jo, zo_ - ZP * 2, 0); zk_[0] = __builtin_amdgcn_raw_buffer_load_b16(zres, jo + 2048, zo_ - ZP * 2, 0); zv_[0] = __builtin_amdgcn_raw_buffer_load_b16(zres, jo, zo_ - ZP * 2 + 4096, 0); } else { zr_[0] = 0; zk_[0] = 0; zv_[0] = 0; } } while (0)
#define SCAN_PREP(opbase, NT) do { _Pragma("unroll") for (int i_ = 0; i_ < (NT); ++i_) \
        rwkv_prep_token((opbase) + i_ * OP_TOK, lane, c, bf2f(zr_[i_ + 1]), bf2f(zk_[i_ + 1]), bf2f(zv_[i_ + 1]), bf2f(zr_[i_]), bf2f(zk_[i_]), bf2f(zv_[i_]), bf2f(e_[i_]), bf2f(a_[i_]), kn_[i_]); } while (0)
    SCAN_LOAD(TP0 * wave, TP0); SCAN_PREP(OP + TP0 * wave * OP_TOK, TP0);
    __syncthreads();
    const int vloc = (wave & 3) * 8 + (lane >> 3), vrow = half * 32 + vloc, k0 = (lane & 7) * 8, l8 = lane & 7;
    f32x2 s[4] = {{0.f, 0.f}, {0.f, 0.f}, {0.f, 0.f}, {0.f, 0.f}};
    for (int cc = 0; cc < NCH; ++cc) {
        const LAS float* opc = OP + (cc & 1) * TC * OP_TOK; LAS float* yb = YB + (cc & 1) * TC * 32;
        if (wave < 4) {
            StepOps8 cur = rwkv_load_ops8(opc, k0, vrow), nxt = cur; float yk[TC / 8];
#pragma unroll
            for (int q = 0; q < TC / 8; ++q) yk[q] = 0.f;
#pragma unroll
            for (int tt = 0; tt < TC; ++tt) { if (tt + 1 < TC) nxt = rwkv_load_ops8(opc + (tt + 1) * OP_TOK, k0, vrow); const float y = rwkv_step_ops8(s, cur);
                yk[tt >> 3] = (l8 == (tt & 7)) ? y : yk[tt >> 3]; cur = nxt; }
#pragma unroll
            for (int q = 0; q < TC / 8; ++q) yb[(l8 + 8 * q) * 32 + vloc] = yk[q];
        } else if (cc + 1 < NCH) {
            const int tf = (cc + 1) * TC + TPW * (wave - 4);
            SCAN_LOAD(tf, TPW); SCAN_PREP(OP + (((cc + 1) & 1) * TC + TPW * (wave - 4)) * OP_TOK, TPW);
        }
        __syncthreads();
#pragma unroll
        for (int q = 0; q < TC / 16; ++q) { const int tt = (tid >> 5) + 16 * q, vv = tid & 31; ybuf[(mrow0 + cc * TC + tt) * 1024 + h * 64 + half * 32 + vv] = yb[tt * 32 + vv]; }
    }
#undef SCAN_LOAD
#undef SCAN_PREP
    if (wave < 4) { float* so = a.out + O_WKVP + ((size_t)(b * 16 + h) * 64 + vrow) * 64 + k0; *(f32x4*)so = (f32x4){s[0].x, s[0].y, s[1].x, s[1].y}; *(f32x4*)(so + 4) = (f32x4){s[2].x, s[2].y, s[3].x, s[3].y}; }
    __syncthreads();
}
__device__ __forceinline__ void scan_sample_pair(const Args& a, LAS unsigned char* lds, int pair) {
    const int tid = threadIdx.x, lane = tid & 63, wave = __builtin_amdgcn_readfirstlane(tid >> 6);
    LAS float* op = (LAS float*)lds + wave * OP_TOK;
    const bf16_t* z = (const bf16_t*)(a.ws + WS_Z); const bf16_t* lo = (const bf16_t*)(a.ws + WS_LORA);
    float* ybuf = (float*)(a.ws + WS_HB); const float* knp = (const float*)(a.ws + WS_RKR);
    const int bs = pair >> 4, h = pair & 15, j = h * 64 + lane, k0 = (lane & 15) * 4;
    const size_t m = (size_t)MPROMPT + bs;
    const float* sh = a.in[I_SSHIFT] + (size_t)bs * RWKV_PROJ;
    const float* sin_ = a.in[I_SWKV] + (size_t)(bs * 16 + h) * 4096 + (lane >> 4) * 64 + k0; float* sout = a.out + O_WKVS + (size_t)(bs * 16 + h) * 4096 + (lane >> 4) * 64 + k0;
    f32x4 sv[16];
#pragma unroll
    for (int rg = 0; rg < 16; ++rg) sv[rg] = *(const f32x4*)(sin_ + rg * 256);
    const RwkvConst c = rwkv_consts(a, h, lane);
    const bf16_t* zr = z + m * ZP + j; const bf16_t* l0 = lo + m * 3072 + j;
    rwkv_prep_token(op, lane, c, bf2f(zr[0]), bf2f(zr[1024]), bf2f(zr[2048]), sh[j], sh[1024 + j], sh[2048 + j], bf2f(l0[0]), bf2f(l0[1024]), knp[m * 16 + h]);
    LDS_WAIT(); asm volatile("" ::: "memory");
#pragma unroll
    for (int rg = 0; rg < 16; ++rg) { const int row = rg * 4 + (lane >> 4);
        f32x2 s01 = sv[rg].lo, s23 = sv[rg].hi;
        const float y = rwkv_step_ops(s01, s23, rwkv_load_ops(op, k0, row));
        *(f32x4*)(sout + rg * 256) = (f32x4){s01.x, s01.y, s23.x, s23.y};
        if ((lane & 15) == 0) ybuf[m * 1024 + h * 64 + row] = y; }
    LDS_WAIT(); asm volatile("" ::: "memory");
}

constexpr int AT_KS = 0, AT_VT = 32768, AT_VTS = 528;
__device__ __forceinline__ float bperm_f(unsigned addr, float v) { return __int_as_float(__builtin_amdgcn_ds_bpermute((int)addr, __float_as_int(v))); }
constexpr int AT_BUF = 66560;
__device__ __forceinline__ void attn_stage2(const Args& a, LAS unsigned char* lds, int u0, int u1) {
    const int tid = threadIdx.x; const bf16_t* z = (const bf16_t*)(a.ws + WS_Z);
    u32x4 kv[2][4], vv[2][4];
#pragma unroll
    for (int uu = 0; uu < 2; ++uu) { const int unit = uu ? u1 : u0, kvh = unit & 3, nb = (unit >> 2) & 15, b = unit >> 6; const long mk0 = (long)b * SEQ + nb * 128 - 128;
#pragma unroll
        for (int i = 0; i < 4; ++i) { const int ch = tid + 512 * i, key = ch >> 3, cc = ch & 7; kv[uu][i] = (u32x4){0u, 0u, 0u, 0u}; vv[uu][i] = (u32x4){0u, 0u, 0u, 0u};
            if (unit >= 0 && (nb > 0 || key >= 128)) { const bf16_t* zr = z + (size_t)(mk0 + key) * ZP + kvh * 64 + cc * 8; kv[uu][i] = *(const u32x4*)(zr + ZK); vv[uu][i] = *(const u32x4*)(zr + ZV); } } }
#pragma unroll
    for (int uu = 0; uu < 2; ++uu) { LAS unsigned char* lb = lds + uu * AT_BUF;
#pragma unroll
        for (int i = 0; i < 4; ++i) { const int ch = tid + 512 * i, key = ch >> 3, cc = ch & 7; const u32x4 w = vv[uu][i];
            *(LAS u32x4*)(lb + AT_KS + key * 128 + ((cc ^ (key & 7)) << 4)) = kv[uu][i];
            LAS bf16_t* vt = (LAS bf16_t*)(lb + AT_VT) + (cc * 8) * (AT_VTS / 2) + ((((key >> 3) ^ cc) << 3) | (key & 7));
            vt[0 * (AT_VTS / 2)] = (bf16_t)(w.x & 0xffff); vt[1 * (AT_VTS / 2)] = (bf16_t)(w.x >> 16); vt[2 * (AT_VTS / 2)] = (bf16_t)(w.y & 0xffff); vt[3 * (AT_VTS / 2)] = (bf16_t)(w.y >> 16);
            vt[4 * (AT_VTS / 2)] = (bf16_t)(w.z & 0xffff); vt[5 * (AT_VTS / 2)] = (bf16_t)(w.z >> 16); vt[6 * (AT_VTS / 2)] = (bf16_t)(w.w & 0xffff); vt[7 * (AT_VTS / 2)] = (bf16_t)(w.w >> 16); } }
}
struct AttnQ { bf16x8 q[4][2]; };
__device__ __forceinline__ AttnQ attn_load_q(const Args& a, int unit) {
    const int kvh = unit & 3, nb = (unit >> 2) & 15, b = unit >> 6, lane = threadIdx.x & 63, wave = __builtin_amdgcn_readfirstlane(threadIdx.x >> 6), c16 = lane & 15, g = lane >> 4;
    const bf16_t* z = (const bf16_t*)(a.ws + WS_Z); const long m0 = (long)b * SEQ + nb * 128; AttnQ r;
#pragma unroll
    for (int it = 0; it < 4; ++it) { const int G_ = wave * 4 + it, head_ = kvh * 4 + (G_ >> 3), i0_ = (G_ & 7) * 16;
        const bf16_t* qp = z + (size_t)(m0 + i0_ + c16) * ZP + ZQ + head_ * 64 + g * 8; r.q[it][0] = *(const bf16x8*)qp; r.q[it][1] = *(const bf16x8*)(qp + 32); }
    return r;
}
__device__ __forceinline__ void attn_compute(const Args& a, LAS unsigned char* lds, int unit, const AttnQ& Q) {
    const int kvh = unit & 3, nb = (unit >> 2) & 15, b = unit >> 6;
    const int tid = threadIdx.x, lane = tid & 63, wave = __builtin_amdgcn_readfirstlane(tid >> 6), c16 = lane & 15, g = lane >> 4;
    bf16_t* mix = (bf16_t*)(a.ws + WS_MIX);
    const long m0 = (long)b * SEQ + nb * 128;
    const unsigned bp16 = (unsigned)((lane ^ 16) << 2), bp32 = (unsigned)((lane ^ 32) << 2);
    constexpr float LOG2E = 1.44269504f, SC2 = 0.125f * 1.44269504f;
#pragma unroll
    for (int it = 0; it < 4; ++it) {
        const int G = wave * 4 + it, hq = G >> 3, q16 = G & 7, head = kvh * 4 + hq, i0 = q16 * 16;
        const float sl2 = exp2f(-0.5f * (float)(head + 1)) * LOG2E, sink2 = a.in[I_SINK][head] * LOG2E;
        f32x4 sc[9];
#pragma unroll
        for (int u = 0; u < 9; ++u) { const int key = 16 * (q16 + u) + c16; f32x4 acc = {0.f, 0.f, 0.f, 0.f};
#pragma unroll
            for (int ks = 0; ks < 2; ++ks) { const bf16x8 kf = *(const LAS bf16x8*)(lds + AT_KS + key * 128 + (((ks * 4 + g) ^ (key & 7)) << 4)); acc = __builtin_amdgcn_mfma_f32_16x16x32_bf16(kf, Q.q[it][ks], acc, 0, 0, 0); }
            sc[u] = acc; }
        float cr[4];
#pragma unroll
        for (int r = 0; r < 4; ++r) cr[r] = -sl2 * (float)(128 + c16 - 4 * g - r);
        float m = -3.0e38f;
#pragma unroll
        for (int u = 0; u < 9; ++u) { const float ct = sl2 * (float)(16 * u);
#pragma unroll
            for (int r = 0; r < 4; ++r) { float v = __builtin_fmaf(sc[u][r], SC2, cr[r]) + ct;
                if (u == 0) v = (c16 < 4 * g + r) ? v : -3.0e38f;
                if (u == 8) v = (c16 >= 4 * g + r) ? v : -3.0e38f;
                sc[u][r] = v; }
            if (nb == 0 && q16 + u < 8) {
#pragma unroll
                for (int r = 0; r < 4; ++r) sc[u][r] = -3.0e38f; }
#pragma unroll
            for (int r = 0; r < 4; ++r) m = fmaxf(m, sc[u][r]); }
        m = fmaxf(m, bperm_f(bp16, m)); m = fmaxf(m, bperm_f(bp32, m));
        const float mx = fmaxf(m, sink2);
        float sum = 0.f;
#pragma unroll
        for (int u = 0; u < 9; ++u)
#pragma unroll
            for (int r = 0; r < 4; ++r) { const float p = __builtin_amdgcn_exp2f(sc[u][r] - mx); sc[u][r] = p; sum += p; }
        sum += bperm_f(bp16, sum); sum += bperm_f(bp32, sum);
        const float inv = __builtin_amdgcn_rcpf(sum + __builtin_amdgcn_exp2f(sink2 - mx));
        f32x4 o[4];
#pragma unroll
        for (int dt = 0; dt < 4; ++dt) o[dt] = (f32x4){0.f, 0.f, 0.f, 0.f};
#pragma unroll
        for (int kt = 0; kt < 5; ++kt) { const int u0 = 2 * kt, u1 = 2 * kt + 1;
            u32x4 pw; pw.x = pk2(sc[u0][0] * inv, sc[u0][1] * inv); pw.y = pk2(sc[u0][2] * inv, sc[u0][3] * inv);
            if (u1 < 9) { pw.z = pk2(sc[u1 < 9 ? u1 : 0][0] * inv, sc[u1 < 9 ? u1 : 0][1] * inv); pw.w = pk2(sc[u1 < 9 ? u1 : 0][2] * inv, sc[u1 < 9 ? u1 : 0][3] * inv); } else { pw.z = 0u; pw.w = 0u; }
            const bf16x8 pf = __builtin_bit_cast(bf16x8, pw);
            const int grp0 = 2 * (q16 + u0) + (g >> 1), grp1 = u1 < 9 ? grp0 + 2 : grp0;
#pragma unroll
            for (int dt = 0; dt < 4; ++dt) { const int row = 16 * dt + c16, sw = (2 * dt + (c16 >> 3)) & 7; const LAS unsigned char* vr = lds + AT_VT + row * AT_VTS + (g & 1) * 8;
                const u32x2 lo = *(const LAS u32x2*)(vr + ((grp0 ^ sw) << 4)), hi = *(const LAS u32x2*)(vr + ((grp1 ^ sw) << 4));
                const u32x4 vw = {lo.x, lo.y, hi.x, hi.y};
                o[dt] = __builtin_amdgcn_mfma_f32_16x16x32_bf16(__builtin_bit_cast(bf16x8, vw), pf, o[dt], 0, 0, 0); } }
        { bf16_t* orow = mix + (size_t)(m0 + i0 + c16) * DM + 1024 + head * 64 + 4 * g;
#pragma unroll
          for (int dt = 0; dt < 4; ++dt) { u32x2 w; w.x = pk2(o[dt][0], o[dt][1]); w.y = pk2(o[dt][2], o[dt][3]); *(u32x2*)(orow + 16 * dt) = w; } }
    }
}
__device__ __forceinline__ void attn_sample_unit(const Args& a, LAS float* scl  , int unit, int lane) {
    const int kvh = unit & 3, bs = unit >> 2, ksub = lane >> 4, dq = (lane & 15) * 4;
    const bf16_t* z = (const bf16_t*)(a.ws + WS_Z); bf16_t* mix = (bf16_t*)(a.ws + WS_MIX);
    const size_t m = (size_t)MPROMPT + bs;
    const float* ck = a.in[I_CK] + ((size_t)bs * 128 * 4 + kvh) * 64 + dq; const float* cv = a.in[I_CV] + ((size_t)bs * 128 * 4 + kvh) * 64 + dq;
    float* ko = a.out + O_KS + ((size_t)bs * 128 * 4 + kvh) * 64 + dq; float* vo = a.out + O_VS + ((size_t)bs * 128 * 4 + kvh) * 64 + dq;
    f32x4 qv[4]; float slope[4], sink[4];
#pragma unroll
    for (int gq = 0; gq < 4; ++gq) { const int head = kvh * 4 + gq; const u32x2 w = *(const u32x2*)(z + m * ZP + ZQ + head * 64 + dq); qv[gq] = (f32x4){bflo(w.x), bfhi(w.x), bflo(w.y), bfhi(w.y)};
        slope[gq] = exp2f(-0.5f * (float)(head + 1)); sink[gq] = a.in[I_SINK][head]; }
    f32x4 knew, vnew;
    { const u32x2 w = *(const u32x2*)(z + m * ZP + ZK + kvh * 64 + dq); knew = (f32x4){bflo(w.x), bfhi(w.x), bflo(w.y), bfhi(w.y)};
      const u32x2 w2 = *(const u32x2*)(z + m * ZP + ZV + kvh * 64 + dq); vnew = (f32x4){bflo(w2.x), bfhi(w2.x), bflo(w2.y), bfhi(w2.y)}; }
#pragma unroll 1
    for (int hb = 0; hb < 4; ++hb) { f32x4 kr[8]; asm volatile("" ::: "memory");
#pragma unroll
        for (int i = 0; i < 8; ++i) { const int s = (hb * 8 + i) * 4 + ksub; const int sr = s < 127 ? s + 1 : 127; kr[i] = *(const f32x4*)(ck + (size_t)sr * 256); }
#pragma unroll
        for (int i = 0; i < 8; ++i) { const int s = (hb * 8 + i) * 4 + ksub; const f32x4 kv = s < 127 ? kr[i] : knew;
            *(f32x4*)(ko + (size_t)s * 256) = kv;
#pragma unroll
            for (int gq = 0; gq < 4; ++gq) { const float p = row16_sum((qv[gq][0] * kv[0] + qv[gq][1] * kv[1]) + (qv[gq][2] * kv[2] + qv[gq][3] * kv[3]));
                if ((lane & 15) == 0) scl[gq * 128 + s] = p * 0.125f - slope[gq] * (float)(127 - s); } } }
    LDS_WAIT(); asm volatile("" ::: "memory");
#pragma unroll
    for (int gq = 0; gq < 4; ++gq) { const float v0 = scl[gq * 128 + lane], v1 = scl[gq * 128 + 64 + lane]; const float mxv = fmaxf(wave_max(fmaxf(v0, v1)), sink[gq]);
        const float p0 = __expf(v0 - mxv), p1 = __expf(v1 - mxv); const float inv = __builtin_amdgcn_rcpf(wave_sum(p0 + p1) + __expf(sink[gq] - mxv));
        scl[gq * 128 + lane] = p0 * inv; scl[gq * 128 + 64 + lane] = p1 * inv; }
    LDS_WAIT(); asm volatile("" ::: "memory");
    f32x4 o[4];
#pragma unroll
    for (int gq = 0; gq < 4; ++gq) o[gq] = (f32x4){0.f, 0.f, 0.f, 0.f};
#pragma unroll 1
    for (int hb = 0; hb < 4; ++hb) { f32x4 vr[8]; asm volatile("" ::: "memory");
#pragma unroll
        for (int i = 0; i < 8; ++i) { const int s = (hb * 8 + i) * 4 + ksub; const int sr = s < 127 ? s + 1 : 127; vr[i] = *(const f32x4*)(cv + (size_t)sr * 256); }
#pragma unroll
        for (int i = 0; i < 8; ++i) { const int s = (hb * 8 + i) * 4 + ksub; const f32x4 vv = s < 127 ? vr[i] : vnew;
            *(f32x4*)(vo + (size_t)s * 256) = vv;
#pragma unroll
            for (int gq = 0; gq < 4; ++gq) o[gq] += scl[gq * 128 + s] * vv; } }
#pragma unroll
    for (int gq = 0; gq < 4; ++gq) {
#pragma unroll
        for (int j = 0; j < 4; ++j) { float t = o[gq][j]; t += __shfl_xor(t, 16); t += __shfl_xor(t, 32); o[gq][j] = t; }
        if (ksub == 0) { u32x2 w; w.x = pk2(o[gq][0], o[gq][1]); w.y = pk2(o[gq][2], o[gq][3]); *(u32x2*)(mix + m * DM + 1024 + (kvh * 4 + gq) * 64 + dq) = w; } }
    LDS_WAIT(); asm volatile("" ::: "memory");
}
__device__ __forceinline__ void p4_mixers(const Args& a, LAS unsigned char* lds, int G) {
    const int tid = threadIdx.x, lane = tid & 63, wave = __builtin_amdgcn_readfirstlane(tid >> 6);
    for (int rep = 0; rep < ((MK_DUP & 4) ? 2 : 1); ++rep) {
    for (int it = blockIdx.x; it < 256; it += G) scan_prompt_item(a, lds, it);
    for (int it = blockIdx.x * 8 + wave; it < NSAMP * 16; it += G * 8) scan_sample_pair(a, lds, it);
    __syncthreads(); }
    for (int rep = 0; rep < ((MK_DUP & 8) ? 2 : 1); ++rep) {
    for (int u = blockIdx.x; u < 512; u += 2 * G) { const int u1 = u + G < 512 ? u + G : -1;
        attn_stage2(a, lds, u, u1); const AttnQ q0 = attn_load_q(a, u);
        __syncthreads();
        attn_compute(a, lds, u, q0);
        if (u1 >= 0) { const AttnQ q1 = attn_load_q(a, u1); attn_compute(a, lds + AT_BUF, u1, q1); }
        __syncthreads(); }
    for (int u = blockIdx.x + G * wave; u < 512; u += G * 8) attn_sample_unit(a, (LAS float*)lds + wave * 512, u, lane);
    __syncthreads(); }
    const bf16_t* z = (const bf16_t*)(a.ws + WS_Z); const int gt = blockIdx.x * 512 + tid, NGT = G * 512;
    for (int i = gt; i < 8 * RWKV_PROJ; i += NGT) { const int b = i / RWKV_PROJ, c = i % RWKV_PROJ; a.out[O_SHP + i] = bf2f(z[((size_t)b * SEQ + SEQ - 1) * ZP + c]); }
    for (int i = gt; i < NSAMP * RWKV_PROJ; i += NGT) { const int b = i / RWKV_PROJ, c = i % RWKV_PROJ; a.out[O_SHS + i] = bf2f(z[((size_t)MPROMPT + b) * ZP + c]); }
    for (int i = gt; i < 8 * 128 * 256; i += NGT) { const int c = i & 255, s = (i >> 8) & 127, b = i >> 15; const bf16_t* zr = z + ((size_t)b * SEQ + SEQ - 128 + s) * ZP;
        a.out[O_KP + i] = bf2f(zr[ZK + c]); a.out[O_VP + i] = bf2f(zr[ZV + c]); }
}

struct P5Raw { f32x4 y; u32x2 zr, zk, zv, aw, gl; };
__device__ __forceinline__ P5Raw p5_load(const bf16_t* z, const bf16_t* lo, const float* ybuf, size_t m, int j) {
    P5Raw r; r.y = *(const f32x4*)(ybuf + m * 1024 + j); const bf16_t* zp = z + m * ZP + j; r.zr = *(const u32x2*)zp; r.zk = *(const u32x2*)(zp + 1024); r.zv = *(const u32x2*)(zp + 2048);
    const bf16_t* lp = lo + m * 3072 + j; r.aw = *(const u32x2*)(lp + 1024); r.gl = *(const u32x2*)(lp + 2048); return r;
}
struct P5Const { f32x4 mu_r, mu_k, mu_v, ka, rk, lw, lb; };
__device__ __forceinline__ void p5_compute(const P5Raw& c, f32x4 pr, f32x4 pk, f32x4 pv, const P5Const& k_, bf16_t* dst) {
    const f32x4 zr = bf4(c.zr), zk = bf4(c.zk), zv = bf4(c.zv), av = bf4(c.aw), gg = bf4(c.gl);
    const f32x4 r = zr + (pr - zr) * k_.mu_r, k = zk + (pk - zk) * k_.mu_k, v = zv + (pv - zv) * k_.mu_v;
    const f32x4 y = c.y;
    const float mean = row16_sum((y[0] + y[1]) + (y[2] + y[3])) * (1.f / 64.f); const f32x4 dy = y - mean;
    const float var = row16_sum((dy[0] * dy[0] + dy[1] * dy[1]) + (dy[2] * dy[2] + dy[3] * dy[3])) * (1.f / 64.f); const float rstd = rsqrtf(var + GN_EPS);
    const f32x4 kh = k * (1.f + (av - 1.f) * k_.ka); const f32x4 t = r * kh * k_.rk;
    const float bon = row16_sum((t[0] + t[1]) + (t[2] + t[3]));
    const f32x4 o = (dy * rstd * k_.lw + k_.lb + bon * v) * gg;
    u32x2 w; w.x = pk2(o[0], o[1]); w.y = pk2(o[2], o[3]); *(u32x2*)dst = w;
}
__device__ __forceinline__ void p5_rwkv_post(const Args& a, int G) {
    const int tid = threadIdx.x, lane = tid & 63, wave = tid >> 6, gw = blockIdx.x * 8 + wave, NGW = G * 8;
    const bf16_t* z = (const bf16_t*)(a.ws + WS_Z); const bf16_t* lo = (const bf16_t*)(a.ws + WS_LORA); bf16_t* mix = (bf16_t*)(a.ws + WS_MIX);
    const float* ybuf = (const float*)(a.ws + WS_HB);
    for (int ck = gw; ck < MPROMPT / 8; ck += NGW) { const size_t m0 = (size_t)(ck >> 2) * 32; const int j = ((ck & 3) * 4 + (lane >> 4)) * 64 + (lane & 15) * 4;
        const P5Const kc{*(const f32x4*)(a.in[I_MU] + j), *(const f32x4*)(a.in[I_MU] + 1024 + j), *(const f32x4*)(a.in[I_MU] + 2048 + j), *(const f32x4*)(a.in[I_KA] + j), *(const f32x4*)(a.in[I_RK] + j), *(const f32x4*)(a.in[I_LNW] + j), *(const f32x4*)(a.in[I_LNB] + j)};
        f32x4 pr = {0.f, 0.f, 0.f, 0.f}, pk = pr, pv = pr; P5Raw ring[4];
#pragma unroll
        for (int i = 0; i < 4; ++i) ring[i] = p5_load(z, lo, ybuf, m0 + i, j);
        if ((m0 % SEQ) != 0) { const bf16_t* zp = z + (m0 - 1) * ZP + j; pr = bf4(*(const u32x2*)zp); pk = bf4(*(const u32x2*)(zp + 1024)); pv = bf4(*(const u32x2*)(zp + 2048)); }
#pragma unroll 1
        for (int t = 0; t < 32; t += 4) {
#pragma unroll
            for (int i = 0; i < 4; ++i) { const size_t m = m0 + t + i; const P5Raw c = ring[i];
                p5_compute(c, pr, pk, pv, kc, mix + m * DM + j);
                pr = bf4(c.zr); pk = bf4(c.zk); pv = bf4(c.zv);
                if (t + 4 < 32) ring[i] = p5_load(z, lo, ybuf, m + 4, j); } }
    }
    for (int q = gw; q < NSAMP * 4; q += NGW) { const size_t m = (size_t)MPROMPT + (q >> 2); const int hg = q & 3, j = (hg * 4 + (lane >> 4)) * 64 + (lane & 15) * 4;
        const float* sh = a.in[I_SSHIFT] + (m - MPROMPT) * RWKV_PROJ + j; const P5Raw c = p5_load(z, lo, ybuf, m, j);
        const P5Const kc{*(const f32x4*)(a.in[I_MU] + j), *(const f32x4*)(a.in[I_MU] + 1024 + j), *(const f32x4*)(a.in[I_MU] + 2048 + j), *(const f32x4*)(a.in[I_KA] + j), *(const f32x4*)(a.in[I_RK] + j), *(const f32x4*)(a.in[I_LNW] + j), *(const f32x4*)(a.in[I_LNB] + j)};
        p5_compute(c, *(const f32x4*)sh, *(const f32x4*)(sh + 1024), *(const f32x4*)(sh + 2048), kc, mix + m * DM + j); }
}

__device__ __forceinline__ void p7_convert_p(const Args& a, int wg, int nwgs) {
    bf16_t* pb = (bf16_t*)(a.ws + WS_PB); const int gt = wg * 512 + threadIdx.x, NGT = nwgs * 512;
    for (int i = gt; i < MP * PLE / 4; i += NGT) { const int m = i / (PLE / 4), c4 = i % (PLE / 4); f32x4 v = {0.f, 0.f, 0.f, 0.f};
        if (m < MPROMPT) v = ((const f32x4*)a.in[I_PP])[(size_t)m * (PLE / 4) + c4]; else if (m < MTOK) v = ((const f32x4*)a.in[I_PS])[(size_t)(m - MPROMPT) * (PLE / 4) + c4];
        u32x2 w; w.x = pk2(v[0], v[1]); w.y = pk2(v[2], v[3]); ((u32x2*)pb)[i] = w; }
}
__device__ __forceinline__ void p10_final_norm(const Args& a, int G) {
    const int tid = threadIdx.x, lane = tid & 63, wave = tid >> 6, gw = blockIdx.x * 8 + wave, NGW = G * 8; const float* ss3 = (const float*)(a.ws + WS_SS3);
    const bf16_t* x3b = (const bf16_t*)(a.ws + WS_X3);
    for (int m = gw; m < MTOK; m += NGW) { const float rs = rsqrtf(ss3[m] * (1.f / DM) + EPS); f32x4* yr = (f32x4*)(a.out + (size_t)m * DM); const u32x4* xr = (const u32x4*)(x3b + (size_t)m * DM);
#pragma unroll
        for (int j = 0; j < 4; ++j) { const u32x4 w = xr[lane + 64 * j]; const f32x4 g0 = ((const f32x4*)a.in[I_FNORM])[2 * (lane + 64 * j)], g1 = ((const f32x4*)a.in[I_FNORM])[2 * (lane + 64 * j) + 1];
            yr[2 * (lane + 64 * j)] = (f32x4){bflo(w.x), bfhi(w.x), bflo(w.y), bfhi(w.y)} * rs * g0; yr[2 * (lane + 64 * j) + 1] = (f32x4){bflo(w.z), bfhi(w.z), bflo(w.w), bfhi(w.w)} * rs * g1; } }
}

typedef GAS unsigned gu32;
#define XB_TMO      128
#define XB_XCNT(j)  (256  + 64 * (j))
#define XB_XSUB(j)  (1280 + 64 * (j))
#define XB_XGEN(j)  (2304 + 64 * (j))
#define XB_TOP      3328
#define XB_TOPGEN   3392
#define XCD_BAR_WORDS 3456
#define XB_SPIN_CAP (1u << 18)
__device__ __forceinline__ unsigned xb_ld(unsigned* p)              { return __hip_atomic_load(p, __ATOMIC_RELAXED, __HIP_MEMORY_SCOPE_AGENT); }
__device__ __forceinline__ unsigned xb_add(unsigned* p, unsigned v) { return __hip_atomic_fetch_add(p, v, __ATOMIC_RELAXED, __HIP_MEMORY_SCOPE_AGENT); }
__device__ __forceinline__ unsigned xb_xcc_id() { return (unsigned)__builtin_amdgcn_s_getreg((3 << 11) | 20) & 0xFu; }
#define XB_SPIN(cond, bar) do { unsigned _sp = 0; while (cond) { __builtin_amdgcn_s_sleep(1); \
    if ((++_sp & 255u) == 0u) { if (xb_ld(&(bar)[XB_TMO])) break; if (_sp > XB_SPIN_CAP) { atomicAdd(&(bar)[XB_TMO], 1u); break; } } } } while (0)
struct XcdBarrier { unsigned* bar; unsigned x; volatile LAS unsigned* st; };
__device__ __forceinline__ XcdBarrier xcd_barrier_post(unsigned* bar, volatile LAS unsigned* st) {
    XcdBarrier b; b.bar = bar; b.x = xb_xcc_id(); b.st = st;
    if (threadIdx.x == 0) (void)xb_add(&bar[XB_XCNT(b.x)], 1u);
    return b;
}
__device__ __forceinline__ void xcd_barrier_complete(unsigned* bar, unsigned x, unsigned& nloc, unsigned& nx) {
    const unsigned G = gridDim.x * gridDim.y * gridDim.z;
    unsigned sum, cnt, mine, sp = 0u;
    for (;;) {
        sum = 0u; cnt = 0u; mine = 0u;
#pragma unroll
        for (unsigned j = 0; j < 16; ++j) { const unsigned c = xb_ld(&bar[XB_XCNT(j)]); sum += c; cnt += (c > 0u) ? 1u : 0u; mine = (j == x) ? c : mine; }
        if (sum == G) break;
        __builtin_amdgcn_s_sleep(1);
        if ((++sp & 255u) == 0u) { if (xb_ld(&bar[XB_TMO])) break; if (sp > XB_SPIN_CAP) { atomicAdd(&bar[XB_TMO], 1u); break; } }
    }
    nloc = mine > 0u ? mine : 1u; nx = cnt > 0u ? cnt : 1u;
}
__device__ __forceinline__ void xcd_barrier(const XcdBarrier& b) {
    asm volatile("s_waitcnt vmcnt(0)" ::: "memory");
    __syncthreads();
    if (threadIdx.x == 0) {
        unsigned* bar = b.bar;
        __builtin_amdgcn_s_waitcnt(0);
        unsigned nloc = b.st[0], nx = b.st[1];
        if (nloc == 0u) { xcd_barrier_complete(bar, b.x, nloc, nx); b.st[0] = nloc; b.st[1] = nx; }
        const unsigned old = xb_add(&bar[XB_XSUB(b.x)], 1u);
        const unsigned gen = old / nloc;
        if (old + 1u == (gen + 1u) * nloc) {
            __builtin_amdgcn_fence(__ATOMIC_RELEASE, "agent");
            asm volatile("s_waitcnt vmcnt(0)" ::: "memory");
            const unsigned og = xb_add(&bar[XB_TOP], 1u);
            const unsigned tg = og / nx;
            if (og + 1u == (tg + 1u) * nx) xb_add(&bar[XB_TOPGEN], 1u);
            else XB_SPIN(xb_ld(&bar[XB_TOPGEN]) == tg, bar);
            __builtin_amdgcn_fence(__ATOMIC_ACQUIRE, "agent");
            xb_add(&bar[XB_XGEN(b.x)], 1u);
            asm volatile("s_waitcnt vmcnt(0)" ::: "memory");
        } else {
            XB_SPIN(xb_ld(&bar[XB_XGEN(b.x)]) == gen, bar);
            __builtin_amdgcn_fence(__ATOMIC_ACQUIRE, "agent");
            asm volatile("s_waitcnt vmcnt(0)" ::: "memory");
        }
    }
    __syncthreads();
}
constexpr int CW_BAR = 4096;
constexpr size_t CTL_ZERO_BYTES = 65536;
constexpr int LDSCTL_OFF = LDS_BYTES - 256;

__global__ void __launch_bounds__(512, 2) mk_fwd(Args a) {
    extern __shared__ __attribute__((aligned(16))) unsigned char lds_raw[];
    LAS unsigned char* lds = (LAS unsigned char*)lds_raw;
    const int G = gridDim.x; unsigned char* ws = a.ws;
    const int lo = a.ph_lo, hi = a.ph_hi;
    for (int u = threadIdx.x; u < 64; u += 512) ((LAS unsigned*)(lds + LDSCTL_OFF))[u] = 0u;
    __syncthreads();
    XcdBarrier bar; bar.bar = (unsigned*)(ws + WS_CTL) + CW_BAR; bar.x = 0; bar.st = nullptr;
    if (hi - lo > 1) bar = xcd_barrier_post((unsigned*)(ws + WS_CTL) + CW_BAR, (volatile LAS unsigned*)(lds + LDSCTL_OFF) + 8);
#define IN(k) (lo <= (k) && (k) < hi)
#define SEAM(k) do { if (IN(k) && IN((k) + 1)) { xcd_barrier(bar); } } while (0)
    if (IN(0)) { if (MK_DUP & 1) { p0_prologue(a, lds, G); __syncthreads(); } p0_prologue(a, lds, G); }
    SEAM(0);
    if (IN(1)) { pg8::Gemm g{(const bf16_t*)(ws + WS_HB), (const bf16_t*)(ws + WS_WIN), MP, ZP, DM, DM, DM, 1 << 30, 0}; pg8::StaticOrder S; S.init(MPROMPT, ZP, G, (int)blockIdx.x, -1, 2 * (ZP / 256), 64);
        pg8::EpiBf16 E{(bf16_t*)(ws + WS_Z), ZP}; pg8::gemm_phase<pg8::EpiBf16>(lds, g, S, E); tail_convert(a, lds, 64 * (ZP / 256) + 2 * (ZP / 256), G, 1, 4); tail_convert(a, lds, 64 * (ZP / 256) + 2 * (ZP / 256), G, 5, 7);
        { const int rem = (64 * (ZP / 256) + 2 * (ZP / 256)) % G, c = (int)blockIdx.x; if (rem == 0) p7_convert_p(a, c, G); else if (c >= rem) p7_convert_p(a, c - rem, G - rem); } }
    SEAM(1);
    if (IN(2)) { if (MK_DUP & 32) p2_lora_fused(a, lds, G); p2_lora_fused(a, lds, G); }
    SEAM(2);
    if (IN(4)) { p4_mixers(a, lds, G); }
    SEAM(4);
    if (IN(5)) { if (MK_DUP & 16) p5_rwkv_post(a, G); p5_rwkv_post(a, G); }
    SEAM(5);
    if (IN(6)) { pg8::Gemm g{(const bf16_t*)(ws + WS_MIX), (const bf16_t*)(ws + WS_WOUT), MP, DM, DM, DM, DM, 1 << 30, 0}; pg8::StaticOrder S; S.init(MPROMPT, DM, G, (int)blockIdx.x, -1, 16, 64);
        pg8::EpiResid E{a.in[I_XP], a.in[I_XS], (bf16_t*)(ws + WS_HB), (float*)(ws + WS_SS1)}; pg8::gemm_phase<pg8::EpiResid>(lds, g, S, E);
        { const int nwg = 64 * (DM / 256) + 16, rem = nwg % G; const int c2 = rem ? (int)blockIdx.x - rem : (int)blockIdx.x, G2 = rem ? G - rem : G;
          if (c2 >= 0) { pg8::Gemm g2{(const bf16_t*)(ws + WS_PB), (const bf16_t*)(ws + WS_WPP), MP, DM, PLE, PLE, PLE, 1 << 30, 0}; pg8::StaticOrder S2; S2.init(MP, DM, G2, c2, 64);
              pg8::EpiBf16 E2{(bf16_t*)(ws + WS_X3), DM}; pg8::gemm_phase<pg8::EpiBf16>(lds, g2, S2, E2); } } }
    SEAM(6);
    if (IN(7)) {
        pg8::Gemm g{(const bf16_t*)(ws + WS_HB), (const bf16_t*)(ws + WS_WGU), MP, 2 * DFF, DM, DM, DM, 1 << 30, 0}; pg8::StaticOrder S; S.init(MPROMPT, 2 * DFF, G, (int)blockIdx.x, -1, 2 * (2 * DFF / 256), 64);
        pg8::EpiGateUp E{(bf16_t*)(ws + WS_HID), (const float*)(ws + WS_SS1)}; pg8::gemm_phase<pg8::EpiGateUp>(lds, g, S, E); tail_convert(a, lds, 64 * 44 + 88, G, 4, 5); }
    SEAM(7);
    if (IN(8)) { pg8::Gemm g{(const bf16_t*)(ws + WS_HID), (const bf16_t*)(ws + WS_WD), MP, DM, DFF, DFF, DFF, 1 << 30, 0}; pg8::StaticOrder S; S.init(MPROMPT, DM, G, (int)blockIdx.x, -1, 0, 64);
        pg8::EpiResid E{nullptr, nullptr, (bf16_t*)(ws + WS_HB), (float*)(ws + WS_SS2)}; pg8::gemm_phase<pg8::EpiResid>(lds, g, S, E);
        skinny_phase<SK_RESID_INPLACE, 2, 1, 4>(lds, SkArgs{(const bf16_t*)(ws + WS_HID) + (size_t)MPROMPT * DFF, DFF, (const bf16_t*)(ws + WS_WD), DFF, DFF, DM, (bf16_t*)(ws + WS_HB), DM, nullptr, (float*)(ws + WS_SS2), nullptr, nullptr, nullptr}, G); }
    SEAM(8);
    if (IN(9)) { pg8::StaticOrder S; S.init(MPROMPT, DM, G, (int)blockIdx.x, -1, 0, 64);
        pg8::Gemm g{(const bf16_t*)(ws + WS_HB), (const bf16_t*)(ws + WS_WPG), MP, DM, DM, DM, DM, 1 << 30, 0};
        pg8::EpiPle E{(const bf16_t*)(ws + WS_HB), (bf16_t*)(ws + WS_X3), (const bf16_t*)(ws + WS_X3), (const float*)(ws + WS_SS2), (float*)(ws + WS_SS3)}; pg8::gemm_phase<pg8::EpiPle>(lds, g, S, E);
        skinny_phase<SK_PLE, 2, 1, 4>(lds, SkArgs{(const bf16_t*)(ws + WS_HB) + (size_t)MPROMPT * DM, DM, (const bf16_t*)(ws + WS_WPG), DM, DM, DM, (bf16_t*)(ws + WS_X3), DM, nullptr, (float*)(ws + WS_SS3), (const float*)(ws + WS_SS2),
            (const bf16_t*)(ws + WS_HB), (const bf16_t*)(ws + WS_X3)}, G); }
    SEAM(9);
    if (IN(10)) { p10_final_norm(a, G); }
#undef IN
#undef SEAM
}

extern "C" void kernel_launch(void* const* d_in, const int* in_sizes, int n_in, void* d_out, int out_size, void* d_ws, size_t ws_size, hipStream_t stream) {
    static int grid = 0;
    if (grid == 0) {
        if (n_in != 31 || ws_size < WS_END) { fprintf(stderr, "kernel_launch: expected 31 inputs and >= %zu bytes of workspace, got %d / %zu\n", (size_t)WS_END, n_in, ws_size); grid = -1; return; }
        int dev = 0, cus = 0;
        if (hipGetDevice(&dev) != hipSuccess || hipDeviceGetAttribute(&cus, hipDeviceAttributeMultiprocessorCount, dev) != hipSuccess) { grid = -1; return; }
        if (hipFuncSetAttribute((const void*)mk_fwd, hipFuncAttributeMaxDynamicSharedMemorySize, LDS_BYTES) != hipSuccess) { fprintf(stderr, "kernel_launch: hipFuncSetAttribute failed\n"); grid = -1; return; }
        grid = cus;
    }
    if (grid < 0) return;
    Args a{};
    for (int i = 0; i < 31; ++i) a.in[i] = (const float*)d_in[i];
    a.out = (float*)d_out; a.ws = (unsigned char*)d_ws;
#if MK_ONE_LAUNCH
    if (hipMemsetAsync((char*)d_ws + WS_CTL, 0, CTL_ZERO_BYTES, stream) != hipSuccess) { fprintf(stderr, "kernel_launch: hipMemsetAsync failed\n"); return; }
    a.ph_lo = 0; a.ph_hi = NPHASE; hipLaunchKernelGGL(mk_fwd, dim3(grid), dim3(512), LDS_BYTES, stream, a);
#else
    for (int p = 0; p < NPHASE; ++p) { a.ph_lo = p; a.ph_hi = p + 1; hipLaunchKernelGGL(mk_fwd, dim3(grid), dim3(512), LDS_BYTES, stream, a); }
#endif
}
```

```cpp
#include <hip/hip_runtime.h>
#include <cstdio>
#include <cstdint>

#define GAS __attribute__((address_space(1)))
#define LAS __attribute__((address_space(3)))
typedef unsigned short bf16_t;
typedef short bf16x8 __attribute__((ext_vector_type(8)));
typedef float f32x4 __attribute__((ext_vector_type(4)));
typedef float f32x2 __attribute__((ext_vector_type(2)));
typedef unsigned u32x4 __attribute__((ext_vector_type(4)));
typedef unsigned u32x2 __attribute__((ext_vector_type(2)));

#ifndef MK_DUP
#define MK_DUP 0
#endif
#ifndef MK_ONE_LAUNCH
#define MK_ONE_LAUNCH 1
#endif

constexpr int DM = 2048, SEQ = 2048, MPROMPT = 16384, NSAMP = 128, MTOK = 16512, MP = 16640;
constexpr int ZP = 5120, PROJ = 5056, RWKV_PROJ = 3520, DFF = 5632, PLE = 256;
constexpr int ZQ = 3520, ZK = 4544, ZV = 4800;
constexpr int ZXW = 3072, ZXA = 3168, ZXG = 3264;
constexpr float EPS = 1e-6f, GN_EPS = 64e-5f;
constexpr size_t O_Y = 0, O_WKVP = 33816576, O_SHP = 34340864, O_KP = 34369024, O_VP = 34631168, O_WKVS = 34893312, O_SHS = 43281920, O_KS = 43732480, O_VS = 47926784;
constexpr size_t MiB = 1u << 20;
constexpr size_t WS_CTL = 0, WS_SS1 = 1 * MiB, WS_SS2 = 1 * MiB + 131072, WS_SS3 = 1 * MiB + 262144, WS_RKR = 2 * MiB;
constexpr size_t WS_WIN = 4 * MiB, WS_WOUT = 24 * MiB, WS_WGU = 32 * MiB, WS_WD = 76 * MiB, WS_WPG = 98 * MiB, WS_WPP = 106 * MiB, WS_WLORA = 107 * MiB;
constexpr size_t WS_HB = 109 * MiB, WS_Z = 174 * MiB, WS_LORA = WS_Z + (size_t)MP * ZP * 2, WS_MIX = 434 * MiB, WS_PB = 499 * MiB, WS_BON = 507 * MiB + 262144, WS_END = 509 * MiB;
constexpr size_t WS_HID = WS_Z, WS_X3 = WS_LORA + 32 * MiB;
static_assert(WS_X3 >= WS_HID + (size_t)MP * DFF * 2 && WS_X3 + (size_t)MP * DM * 2 <= WS_MIX, "ws map 3");
static_assert(WS_LORA + (size_t)MP * 3072 * 2 <= WS_MIX, "ws map");
static_assert(WS_MIX + (size_t)MP * DM * 2 <= WS_PB && WS_PB + (size_t)MP * PLE * 2 <= WS_BON && WS_BON + (size_t)MP * 16 * 4 <= WS_END, "ws map 2");
constexpr int LDS_BYTES = 147456;
constexpr int NPHASE = 11;

typedef __bf16 bf16x2_t __attribute__((ext_vector_type(2)));
__device__ __forceinline__ unsigned pk2(float lo, float hi) { const f32x2 f = {lo, hi}; return __builtin_bit_cast(unsigned, __builtin_convertvector(f, bf16x2_t)); }
__device__ __forceinline__ unsigned f2bf(float f) { return pk2(f, 0.f) & 0xffffu; }
__device__ __forceinline__ float bf2f(unsigned b) { return __uint_as_float(b << 16); }
__device__ __forceinline__ float bflo(unsigned w) { return __uint_as_float(w << 16); }
__device__ __forceinline__ float bfhi(unsigned w) { return __uint_as_float(w & 0xffff0000u); }
__device__ __forceinline__ unsigned cvt_pk_bf16(float lo, float hi) { return pk2(lo, hi); }
template <int CTRL> __device__ __forceinline__ float dpp_f(float x) { return __int_as_float(__builtin_amdgcn_update_dpp(0, __float_as_int(x), CTRL, 0xf, 0xf, true)); }
__device__ __forceinline__ float row16_sum(float x) { x += dpp_f<0xB1>(x); x += dpp_f<0x4E>(x); x += dpp_f<0x124>(x); x += dpp_f<0x128>(x); return x; }
__device__ __forceinline__ float row8_sum(float x) { x += dpp_f<0xB1>(x); x += dpp_f<0x4E>(x); x += dpp_f<0x141>(x); return x; }
__device__ __forceinline__ float row16_max(float x) { x = fmaxf(x, dpp_f<0xB1>(x)); x = fmaxf(x, dpp_f<0x4E>(x)); x = fmaxf(x, dpp_f<0x124>(x)); x = fmaxf(x, dpp_f<0x128>(x)); return x; }
__device__ __forceinline__ float wave_sum(float v) { v = row16_sum(v); v += __shfl_xor(v, 16); v += __shfl_xor(v, 32); return v; }
__device__ __forceinline__ float wave_max(float v) { v = row16_max(v); v = fmaxf(v, __shfl_xor(v, 16)); v = fmaxf(v, __shfl_xor(v, 32)); return v; }
__device__ __forceinline__ float sigmoidf_(float x) { return __builtin_amdgcn_rcpf(1.f + __expf(-x)); }
__device__ __forceinline__ f32x4 bf4(u32x2 w) { return (f32x4){bflo(w.x), bfhi(w.x), bflo(w.y), bfhi(w.y)}; }
#define LDS_WAIT() asm volatile("s_waitcnt lgkmcnt(0)" ::: "memory")

namespace pg8 {
constexpr int BM = 256, BK = 64, HALF = 128, HTB = HALF * BK * 2, STAGE_BYTES = 8 * HTB, NXCD = 8, WGM = 2;
__host__ __device__ __forceinline__ int lds_byte(int r, int c) { const int st = (r >> 4) * 2 + (c >> 5), rr = r & 15, cc = c & 31, ob = rr * 64 + cc * 2; return st * 1024 + (ob ^ (((ob >> 9) & 1) << 5)); }
__host__ __device__ __forceinline__ void stage_rc(int b, int& R, int& C) { const int st = b / 1024, sb = b % 1024, swz = sb ^ (((sb >> 9) & 1) << 5); R = (st >> 1) * 16 + swz / 64; C = (st & 1) * 32 + (swz % 64) / 2; }
__host__ __device__ __forceinline__ int perm32(int rho) { const int n = rho >> 4, i = rho & 15; return 8 * (i >> 2) + 4 * n + (i & 3); }
struct Unit { int pm, pn, mode;
    __device__ __forceinline__ int cb() const { return mode == 2 ? pn * HALF : pn * BM; } };
struct Gemm { const bf16_t* A; const bf16_t* Bt; int M, N, K, lda, ldb, akdiv, akmul; };
struct StaticOrder {
    int nM, nN, nwg, G, c, nreg, half_pm, fold_pm;
    __host__ __device__ void init(int M, int N, int G_, int c_, int half_pm_ = -1, int nfold = 0, int fold_pm_ = 0) { nM = M / BM; nN = N / BM; nreg = nM * nN; nwg = nreg + nfold; G = G_; c = c_; half_pm = half_pm_; fold_pm = fold_pm_; }
    __host__ __device__ bool next(int i, Unit& u) const {
        const long L = (long)i * G + c; if (L >= nwg) return false;
        if (L >= nreg) { u.pm = fold_pm; u.pn = (int)L - nreg; u.mode = 2; return true; }
        int wgid = (int)L; { const int q = nreg / NXCD, r = nreg % NXCD, xcd = wgid % NXCD, off = wgid / NXCD; wgid = (xcd < r ? xcd * (q + 1) : r * (q + 1) + (xcd - r) * q) + off; }
        const int nig = WGM * nN, gid = wgid / nig, fm = gid * WGM, gsz = (nM - fm) < WGM ? (nM - fm) : WGM;
        u.pm = fm + ((wgid % nig) % gsz); u.pn = (wgid % nig) / gsz; u.mode = (u.pm == half_pm) ? 1 : 0; return true;
    }
};
struct EpiBf16 {
    bf16_t* O; int ldc;
    __device__ __forceinline__ void operator()(const f32x4 (&acc)[2][2][4][2], const Unit& u, int wr, int wc, int fr, int fq) const {
        const int row0 = u.pm * BM + wr * 64 + fr, col0 = u.cb() + wc * 32 + 8 * fq; const bool fold = u.mode == 2;
#pragma unroll
        for (int ai = 0; ai < 2; ++ai)
#pragma unroll
            for (int m = 0; m < 4; ++m) { bf16_t* rowp = O + (size_t)(row0 + ai * HALF + m * 16) * ldc + col0;
#pragma unroll
                for (int bj = 0; bj < 2; ++bj) { if (fold && (ai | bj)) continue; const f32x4 v0 = acc[ai][bj][m][0], v1 = acc[ai][bj][m][1];
                    u32x4 w; w.x = cvt_pk_bf16(v0[0], v0[1]); w.y = cvt_pk_bf16(v0[2], v0[3]); w.z = cvt_pk_bf16(v1[0], v1[1]); w.w = cvt_pk_bf16(v1[2], v1[3]);
                    *(u32x4*)(rowp + bj * HALF) = w; } }
    }
};
struct EpiLora {
    bf16_t* O; const float* w0; const float* a0;
    __device__ __forceinline__ void operator()(const f32x4 (&acc)[2][2][4][2], const Unit& u, int wr, int wc, int fr, int fq) const {
        const int row0 = u.pm * BM + wr * 64 + fr, col0 = u.pn * BM + wc * 32 + 8 * fq, kind = u.pn >> 2, cb = (u.pn & 3) * BM + wc * 32 + 8 * fq;
        const float* bias = (kind == 0 ? w0 : a0) + cb; const float sc = kind == 0 ? 0.60653066f : 1.f;
#pragma unroll
        for (int bj = 0; bj < 2; ++bj) {
            f32x4 b0 = {0.f, 0.f, 0.f, 0.f}, b1 = {0.f, 0.f, 0.f, 0.f};
            if (kind < 2) { b0 = *(const f32x4*)(bias + bj * HALF); b1 = *(const f32x4*)(bias + bj * HALF + 4); }
#pragma unroll
            for (int ai = 0; ai < 2; ++ai)
#pragma unroll
                for (int m = 0; m < 4; ++m) { bf16_t* rowp = O + (size_t)(row0 + ai * HALF + m * 16) * 3072 + col0 + bj * HALF;
                    f32x4 v0 = acc[ai][bj][m][0] + b0, v1 = acc[ai][bj][m][1] + b1;
                    if (kind < 2) {
#pragma unroll
                        for (int j = 0; j < 4; ++j) { v0[j] = sc * sigmoidf_(v0[j]); v1[j] = sc * sigmoidf_(v1[j]); } }
                    u32x4 w; w.x = cvt_pk_bf16(v0[0], v0[1]); w.y = cvt_pk_bf16(v0[2], v0[3]); w.z = cvt_pk_bf16(v1[0], v1[1]); w.w = cvt_pk_bf16(v1[2], v1[3]);
                    *(u32x4*)rowp = w; } }
    }
};
struct EpiResid {
    const float* xp; const float* xs; bf16_t* xb; float* ss;
    __device__ __forceinline__ void operator()(const f32x4 (&acc)[2][2][4][2], const Unit& u, int wr, int wc, int fr, int fq) const {
        const int row0 = u.pm * BM + wr * 64 + fr, col0 = u.cb() + wc * 32 + 8 * fq; const bool fold = u.mode == 2;
#pragma unroll
        for (int ai = 0; ai < 2; ++ai)
#pragma unroll
            for (int mp = 0; mp < 2; ++mp) {
                if (fold && ai) continue;
                f32x4 o[2][2][2]; bool live[2]; int rows[2];
#pragma unroll
                for (int mm = 0; mm < 2; ++mm) { const int row = row0 + ai * HALF + (2 * mp + mm) * 16; rows[mm] = row; live[mm] = row < MTOK; const int rl = live[mm] ? row : 0;
                    if (xp) { const float* src = (rl < MPROMPT ? xp + (size_t)rl * DM : xs + (size_t)(rl - MPROMPT) * DM) + col0;
#pragma unroll
                        for (int bj = 0; bj < 2; ++bj) { if (fold && bj) continue; o[mm][bj][0] = __builtin_nontemporal_load((const f32x4*)(src + bj * HALF)); o[mm][bj][1] = __builtin_nontemporal_load((const f32x4*)(src + bj * HALF + 4)); } }
                    else {
#pragma unroll
                        for (int bj = 0; bj < 2; ++bj) { if (fold && bj) continue; const u32x4 w = *(const u32x4*)(xb + (size_t)rl * DM + col0 + bj * HALF);
                            o[mm][bj][0] = (f32x4){bflo(w.x), bfhi(w.x), bflo(w.y), bfhi(w.y)}; o[mm][bj][1] = (f32x4){bflo(w.z), bfhi(w.z), bflo(w.w), bfhi(w.w)}; } } }
#pragma unroll
                for (int mm = 0; mm < 2; ++mm) { const int m = 2 * mp + mm, row = rows[mm]; float q = 0.f;
#pragma unroll
                    for (int bj = 0; bj < 2; ++bj) { if (fold && bj) continue; const f32x4 v0 = acc[ai][bj][m][0] + o[mm][bj][0], v1 = acc[ai][bj][m][1] + o[mm][bj][1];
                        q += (v0[0] * v0[0] + v0[1] * v0[1]) + (v0[2] * v0[2] + v0[3] * v0[3]) + (v1[0] * v1[0] + v1[1] * v1[1]) + (v1[2] * v1[2] + v1[3] * v1[3]);
                        u32x4 w; w.x = cvt_pk_bf16(v0[0], v0[1]); w.y = cvt_pk_bf16(v0[2], v0[3]); w.z = cvt_pk_bf16(v1[0], v1[1]); w.w = cvt_pk_bf16(v1[2], v1[3]);
                        if (live[mm]) *(u32x4*)(xb + (size_t)row * DM + col0 + bj * HALF) = w; }
                    q += __shfl_xor(q, 16); q += __shfl_xor(q, 32);
                    if (fq == 0 && live[mm]) atomicAdd(ss + row, q); } }
    }
};
struct EpiGateUp {
    bf16_t* H; const float* ss;
    __device__ __forceinline__ void operator()(const f32x4 (&acc)[2][2][4][2], const Unit& u, int wr, int wc, int fr, int fq) const {
        const int row0 = u.pm * BM + wr * 64 + fr, colh = (u.cb() + wc * 32 + 8 * fq) >> 1; const bool fold = u.mode == 2;
        const int colw = ((u.cb() + wc * 32) >> 1) + ((fq & 1) ? 64 + 4 * (fq - 1) : 4 * fq);
#pragma unroll
        for (int ai = 0; ai < 2; ++ai)
#pragma unroll
            for (int m = 0; m < 4; ++m) { if (fold && ai) continue; const int row = row0 + ai * HALF + m * 16; const float rs = rsqrtf(ss[row] * (1.f / DM) + EPS);
                u32x2 w[2];
#pragma unroll
                for (int bj = 0; bj < 2; ++bj) { float h[4];
#pragma unroll
                    for (int j = 0; j < 4; ++j) { const float g = acc[ai][bj][m][0][j] * rs, uu = acc[ai][bj][m][1][j] * rs; h[j] = g * sigmoidf_(g) * uu; }
                    w[bj].x = cvt_pk_bf16(h[0], h[1]); w[bj].y = cvt_pk_bf16(h[2], h[3]); }
                if (fold) *(u32x2*)(H + (size_t)row * DFF + colh) = w[0];
                else { const auto sx = __builtin_amdgcn_permlane16_swap(w[0].x, w[1].x, false, false); const auto sy = __builtin_amdgcn_permlane16_swap(w[0].y, w[1].y, false, false);
                    const u32x4 o = {sx[0], sy[0], sx[1], sy[1]}; *(u32x4*)(H + (size_t)row * DFF + colw) = o; } }
    }
};
struct EpiPle {
    const bf16_t* x2b; bf16_t* x3b; const bf16_t* pp; const float* ss2; float* ss3;
    __device__ __forceinline__ void operator()(const f32x4 (&acc)[2][2][4][2], const Unit& u, int wr, int wc, int fr, int fq) const {
        const int row0 = u.pm * BM + wr * 64 + fr, col0 = u.cb() + wc * 32 + 8 * fq; const bool fold = u.mode == 2;
#pragma unroll
        for (int ai = 0; ai < 2; ++ai)
#pragma unroll
            for (int mp = 0; mp < 2; ++mp) {
                if (fold && ai) continue;
                u32x4 xw[2][2], pw[2][2]; bool live[2]; int rows[2]; float rs[2];
#pragma unroll
                for (int mm = 0; mm < 2; ++mm) { const int row = row0 + ai * HALF + (2 * mp + mm) * 16; rows[mm] = row; live[mm] = row < MTOK; const int rl = live[mm] ? row : 0;
                    rs[mm] = rsqrtf(ss2[rl] * (1.f / DM) + EPS);
#pragma unroll
                    for (int bj = 0; bj < 2; ++bj) { if (fold && bj) continue; xw[mm][bj] = *(const u32x4*)(x2b + (size_t)rl * DM + col0 + bj * HALF); pw[mm][bj] = *(const u32x4*)(pp + (size_t)rl * DM + col0 + bj * HALF); } }
#pragma unroll
                for (int mm = 0; mm < 2; ++mm) { const int m = 2 * mp + mm, row = rows[mm]; float q = 0.f;
#pragma unroll
                    for (int bj = 0; bj < 2; ++bj) { if (fold && bj) continue; const u32x4 xx = xw[mm][bj], p = pw[mm][bj]; const f32x4 a0 = acc[ai][bj][m][0] * rs[mm], a1 = acc[ai][bj][m][1] * rs[mm];
                        f32x4 x0 = {bflo(xx.x), bfhi(xx.x), bflo(xx.y), bfhi(xx.y)}, x1 = {bflo(xx.z), bfhi(xx.z), bflo(xx.w), bfhi(xx.w)};
                        x0[0] += sigmoidf_(a0[0]) * bflo(p.x); x0[1] += sigmoidf_(a0[1]) * bfhi(p.x); x0[2] += sigmoidf_(a0[2]) * bflo(p.y); x0[3] += sigmoidf_(a0[3]) * bfhi(p.y);
                        x1[0] += sigmoidf_(a1[0]) * bflo(p.z); x1[1] += sigmoidf_(a1[1]) * bfhi(p.z); x1[2] += sigmoidf_(a1[2]) * bflo(p.w); x1[3] += sigmoidf_(a1[3]) * bfhi(p.w);
                        u32x4 w; w.x = cvt_pk_bf16(x0[0], x0[1]); w.y = cvt_pk_bf16(x0[2], x0[3]); w.z = cvt_pk_bf16(x1[0], x1[1]); w.w = cvt_pk_bf16(x1[2], x1[3]);
                        if (live[mm]) *(u32x4*)(x3b + (size_t)row * DM + col0 + bj * HALF) = w;
                        q += (x0[0] * x0[0] + x0[1] * x0[1]) + (x0[2] * x0[2] + x0[3] * x0[3]) + (x1[0] * x1[0] + x1[1] * x1[1]) + (x1[2] * x1[2] + x1[3] * x1[3]); }
                    q += __shfl_xor(q, 16); q += __shfl_xor(q, 32);
                    if (fq == 0 && live[mm]) atomicAdd(ss3 + row, q); } }
    }
};

template <class Epi, bool ALIGN_EPI = true, bool SP2 = true>
__device__ __forceinline__ void gemm_phase(LAS unsigned char* lds, const Gemm g, const StaticOrder& S, const Epi& E) {
    const int tid = threadIdx.x, wid = __builtin_amdgcn_readfirstlane(tid >> 6), lane = tid & 63, wr = wid >> 2, wc = wid & 3, fr = lane & 15, fq = lane >> 4;
    const int K = g.K, nt = K / BK;
    unsigned voffA[2], voffB[2];
#pragma unroll
    for (int i = 0; i < 2; ++i) { int R, C; stage_rc(tid * 16 + i * 8192, R, C); const int Rb = (R & ~31) + perm32(R & 31);
        voffA[i] = (unsigned)(R * g.lda + C) * 2u; voffB[i] = (unsigned)(Rb * g.ldb + C) * 2u; }
    const size_t kstep = (size_t)(BK * 2);
    const size_t hstepA = (size_t)HALF * g.lda * 2, hstepB = (size_t)HALF * g.ldb * 2;
    const size_t tstepA = 2 * hstepA, tstepB = 2 * hstepB;
    const unsigned ldsw = (unsigned)wid * 1024u;
    const int aoff = lds_byte(wr * 64 + fr, fq * 8), boff = lds_byte(wc * 32 + fr, fq * 8);
#define PG8_SA(b, h) (((b) * 2 + (h)) * HTB)
#define PG8_SB(b, h) ((4 + (b) * 2 + (h)) * HTB)
#define PG8_STAGE(bufoff, gbase, voff) do { _Pragma("unroll") for (int _i = 0; _i < 2; ++_i) \
        __builtin_amdgcn_global_load_lds((const unsigned*)((const char*)(gbase) + (voff)[_i]), (LAS unsigned*)(lds + (bufoff) + ldsw + _i * 8192), 16, 0, 0); } while (0)
#define PG8_LDA(dst, b, h) do { _Pragma("unroll") for (int m = 0; m < 4; ++m) _Pragma("unroll") for (int k = 0; k < 2; ++k) dst[m][k] = *(const LAS bf16x8*)(lds + PG8_SA(b, h) + aoff + m * 2048 + k * 1024); } while (0)
#define PG8_LDB(dst, b, h) do { _Pragma("unroll") for (int n = 0; n < 2; ++n) _Pragma("unroll") for (int k = 0; k < 2; ++k) dst[n][k] = *(const LAS bf16x8*)(lds + PG8_SB(b, h) + boff + n * 2048 + k * 1024); } while (0)
#define PG8_MMA(ai, bj, At, Bt) do { __builtin_amdgcn_s_setprio(1); _Pragma("unroll") for (int m = 0; m < 4; ++m) _Pragma("unroll") for (int n = 0; n < 2; ++n) _Pragma("unroll") for (int k = 0; k < 2; ++k) \
        acc[ai][bj][m][n] = __builtin_amdgcn_mfma_f32_16x16x32_bf16(Bt[n][k], At[m][k], acc[ai][bj][m][n], 0, 0, 0); __builtin_amdgcn_s_setprio(0); } while (0)
#define PG8_WAIT_V(n) asm volatile("s_waitcnt vmcnt(" #n ")" ::: "memory")
#define PG8_WAIT_L(n) asm volatile("s_waitcnt lgkmcnt(" #n ")" ::: "memory")
#define PG8_BAR __builtin_amdgcn_s_barrier()
#define PG8_SCHED __builtin_amdgcn_sched_barrier(0)
    Unit cur, nxt; int ui = 0;
    if (!S.next(0, cur)) return;
    f32x4 acc[2][2][4][2];
#pragma unroll
    for (int a = 0; a < 2; ++a)
#pragma unroll
        for (int b = 0; b < 2; ++b)
#pragma unroll
            for (int m = 0; m < 4; ++m)
#pragma unroll
                for (int n = 0; n < 2; ++n) acc[a][b][m][n] = (f32x4){0.f, 0.f, 0.f, 0.f};
    bf16x8 At[4][2], B0[2][2], B1[2][2];
    const size_t khalf = (size_t)K;
#define PG8_UNIT(u, pa, pb, ha, hb, nk) do { if ((u).mode == 2) { pa = (const char*)g.A + (size_t)(u).pm * tstepA; pb = (const char*)g.Bt + (size_t)(u).pn * hstepB; ha = khalf; hb = khalf; nk = nt >> 1; } \
        else { pa = (const char*)g.A + (size_t)(u).pm * tstepA + (size_t)(((u).pn / g.akdiv) * g.akmul) * 2; pb = (const char*)g.Bt + (size_t)(u).pn * tstepB; ha = hstepA; hb = hstepB; nk = nt; } } while (0)
    const char* cA; const char* cB; size_t chA, chB; int cnk;
    PG8_UNIT(cur, cA, cB, chA, chB, cnk);
    if constexpr (SP2) {
        PG8_STAGE(PG8_SB(0, 0), cB, voffB); PG8_STAGE(PG8_SB(0, 1), cB + chB, voffB); PG8_STAGE(PG8_SA(0, 0), cA, voffA); PG8_STAGE(PG8_SA(0, 1), cA + chA, voffA);
        if (wr == 1) PG8_BAR;
        PG8_WAIT_V(2); PG8_BAR;
        PG8_STAGE(PG8_SB(1, 0), cB + kstep, voffB); PG8_STAGE(PG8_SA(1, 0), cA + kstep, voffA); PG8_STAGE(PG8_SB(1, 1), cB + chB + kstep, voffB);
        PG8_WAIT_V(6); PG8_BAR;
    }
    for (;;) {
        const bool has_next = S.next(ui + 1, nxt);
        const int mode = cur.mode;
        const char* nA = cA; const char* nB = cB; size_t nhA = chA, nhB = chB; int nnk = cnk;
        if (has_next) PG8_UNIT(nxt, nA, nB, nhA, nhB, nnk);
        for (int t = 0; t < cnk; t += 2) {
            const bool last = (t == cnk - 2);
            const char* a1 = cA + (size_t)(t + 1) * kstep;
            const char* a2 = last ? nA : cA + (size_t)(t + 2) * kstep; const char* b2 = last ? nB : cB + (size_t)(t + 2) * kstep;
            const size_t hA2 = last ? nhA : chA, hB2 = last ? nhB : chB;
            const char* a3 = a2 + kstep; const char* b3 = b2 + kstep;
            PG8_LDB(B0, 0, 0); PG8_LDB(B1, 0, 1); PG8_SCHED; PG8_LDA(At, 0, 0); PG8_STAGE(PG8_SA(1, 1), a1 + chA, voffA);
            PG8_WAIT_V(8); PG8_WAIT_L(0); PG8_BAR; PG8_MMA(0, 0, At, B0); if (mode != 2) PG8_MMA(0, 1, At, B1); PG8_BAR; PG8_SCHED;
            if (mode != 1) PG8_LDA(At, 0, 1); PG8_STAGE(PG8_SB(0, 0), b2, voffB); PG8_STAGE(PG8_SB(0, 1), b2 + hB2, voffB); PG8_STAGE(PG8_SA(0, 0), a2, voffA);
            PG8_WAIT_V(8); PG8_WAIT_L(0); PG8_BAR; if (mode == 0) PG8_MMA(1, 0, At, B0); if (mode != 1) PG8_MMA(1, 1, At, B1); PG8_BAR; PG8_SCHED;
            PG8_LDB(B0, 1, 0); PG8_LDB(B1, 1, 1); PG8_SCHED; PG8_LDA(At, 1, 0); PG8_STAGE(PG8_SA(0, 1), a2 + hA2, voffA);
            PG8_WAIT_V(8); PG8_WAIT_L(0); PG8_BAR; PG8_MMA(0, 0, At, B0); if (mode != 2) PG8_MMA(0, 1, At, B1); PG8_BAR; PG8_SCHED;
            if (mode != 1) PG8_LDA(At, 1, 1); PG8_STAGE(PG8_SB(1, 0), b3, voffB); PG8_STAGE(PG8_SB(1, 1), b3 + hB2, voffB); PG8_STAGE(PG8_SA(1, 0), a3, voffA);
            PG8_WAIT_V(8); PG8_WAIT_L(0); PG8_BAR; if (mode == 0) PG8_MMA(1, 0, At, B0); if (mode != 1) PG8_MMA(1, 1, At, B1); PG8_BAR; PG8_SCHED;
        }
        if constexpr (ALIGN_EPI) { if (wr == 0) PG8_BAR; }
        if (mode == 2) {
#pragma unroll
            for (int m = 0; m < 4; ++m)
#pragma unroll
                for (int n = 0; n < 2; ++n) acc[0][0][m][n] += acc[1][1][m][n]; }
        { int fr_ = fr, fq_ = fq; asm volatile("" : "+v"(fr_), "+v"(fq_));
          E(acc, cur, wr, wc, fr_, fq_); }
        if (!has_next) break;
#pragma unroll
        for (int a = 0; a < 2; ++a)
#pragma unroll
            for (int b = 0; b < 2; ++b)
#pragma unroll
                for (int m = 0; m < 4; ++m)
#pragma unroll
                    for (int n = 0; n < 2; ++n) acc[a][b][m][n] = (f32x4){0.f, 0.f, 0.f, 0.f};
        cur = nxt; cA = nA; cB = nB; chA = nhA; chB = nhB; cnk = nnk; ++ui;
        if constexpr (ALIGN_EPI) { if (wr == 1) PG8_BAR; }
    }
#undef PG8_UNIT
    PG8_WAIT_V(0);
    if constexpr (!ALIGN_EPI) { if (wr == 0) PG8_BAR; }
    PG8_BAR;
#undef PG8_SA
#undef PG8_SB
#undef PG8_STAGE
#undef PG8_LDA
#undef PG8_LDB
#undef PG8_MMA
#undef PG8_WAIT_V
#undef PG8_WAIT_L
#undef PG8_BAR
#undef PG8_SCHED
}
}

enum { SK_BF16 = 0, SK_RESID_F32, SK_RESID_INPLACE, SK_GATEUP, SK_PLE };
struct SkArgs { const bf16_t* A; int lda; const bf16_t* Bt; int ldb; int K, N; bf16_t* out; int ldo; const float* xs; float* ssout; const float* ssin; const bf16_t* x2b; const bf16_t* pp; };
template <int KIND, int MH, int NT, int D>
__device__ __forceinline__ void skinny_phase(LAS unsigned char* lds, const SkArgs s, int G) {
    constexpr int RT = 8 / MH, RM = 128 / MH, LD = 16 * NT + 4;
    static_assert(MH == 1 || NT == 1, "column batching only with full rows");
    const int tid = threadIdx.x, lane = tid & 63, wave = __builtin_amdgcn_readfirstlane(tid >> 6), c16 = lane & 15, g = lane >> 4;
    const int T = s.N / 16, I = T * MH, c = (int)blockIdx.x;
    const int i_lo = (int)((long)c * I / G), i_hi = (int)((long)(c + 1) * I / G);
    const int kw = s.K / 8, kb = wave * kw, nsteps = kw / 32;
    LAS float* part = (LAS float*)lds;
    for (int it0 = i_lo; it0 < i_hi; it0 += NT) {
        const int nct = (i_hi - it0) < NT ? (i_hi - it0) : NT, ct0 = it0 / MH, rh = it0 % MH;
        f32x4 acc[RT][NT];
#pragma unroll
        for (int rt = 0; rt < RT; ++rt)
#pragma unroll
            for (int j = 0; j < NT; ++j) acc[rt][j] = (f32x4){0.f, 0.f, 0.f, 0.f};
        const bf16_t* pa = s.A + (size_t)(RM * rh + c16) * s.lda + kb + 8 * g;
        const bf16_t* pb[NT];
#pragma unroll
        for (int j = 0; j < NT; ++j) pb[j] = s.Bt + (size_t)(16 * (ct0 + (j < nct ? j : 0)) + c16) * s.ldb + kb + 8 * g;
        const size_t rstep = (size_t)16 * s.lda;
        bf16x8 ar[D][RT], br[D][NT];
#define SK_LOAD(d, st) do { _Pragma("unroll") for (int rt = 0; rt < RT; ++rt) ar[d][rt] = *(const bf16x8*)(pa + rt * rstep + 32 * (st)); \
        _Pragma("unroll") for (int j = 0; j < NT; ++j) br[d][j] = *(const bf16x8*)(pb[j] + 32 * (st)); } while (0)
#define SK_MMA(d) do { _Pragma("unroll") for (int rt = 0; rt < RT; ++rt) _Pragma("unroll") for (int j = 0; j < NT; ++j) acc[rt][j] = __builtin_amdgcn_mfma_f32_16x16x32_bf16(ar[d][rt], br[d][j], acc[rt][j], 0, 0, 0); } while (0)
#pragma unroll
        for (int d = 0; d < D; ++d) if (d < nsteps) SK_LOAD(d, d);
#pragma unroll 1
        for (int st = 0; st < nsteps; st += D) {
#pragma unroll
            for (int d = 0; d < D; ++d) if (st + d < nsteps) { SK_MMA(d); if (st + d + D < nsteps) SK_LOAD(d, st + d + D); } }
#undef SK_LOAD
#undef SK_MMA
#pragma unroll
        for (int h = 0; h < RM / 64; ++h) {
#pragma unroll
            for (int rq = 0; rq < 4; ++rq)
#pragma unroll
                for (int j = 0; j < NT; ++j)
#pragma unroll
                    for (int r = 0; r < 4; ++r) part[(wave * 64 + 16 * rq + 4 * g + r) * LD + 16 * j + c16] = acc[4 * h + rq][j][r];
            __syncthreads();
            { const int row = tid >> 3, cg = tid & 7, R = RM * rh + 64 * h + row; const size_t m = (size_t)MPROMPT + R;
              const int la = KIND == SK_GATEUP ? 8 * (cg >> 2) + (cg & 3) : 2 * cg, lb = KIND == SK_GATEUP ? la + 4 : la + 1;
              float q = 0.f, rs = 0.f;
              if (KIND == SK_GATEUP || KIND == SK_PLE) rs = rsqrtf(s.ssin[m] * (1.f / DM) + EPS);
              for (int j = 0; j < nct; ++j) { float vA = 0.f, vB = 0.f;
#pragma unroll
                  for (int w = 0; w < 8; ++w) { vA += part[(w * 64 + row) * LD + 16 * j + la]; vB += part[(w * 64 + row) * LD + 16 * j + lb]; }
                  const int col = 16 * (ct0 + j) + la;
                  if (KIND == SK_BF16) { *(unsigned*)(s.out + m * s.ldo + col) = pk2(vA, vB); }
                  else if (KIND == SK_RESID_F32) { const f32x2 xo = *(const f32x2*)(s.xs + (size_t)R * DM + col); vA += xo.x; vB += xo.y; *(unsigned*)(s.out + m * DM + col) = pk2(vA, vB); q += vA * vA + vB * vB; }
                  else if (KIND == SK_RESID_INPLACE) { const unsigned wo = *(const unsigned*)(s.out + m * DM + col); vA += bflo(wo); vB += bfhi(wo); *(unsigned*)(s.out + m * DM + col) = pk2(vA, vB); q += vA * vA + vB * vB; }
                  else if (KIND == SK_GATEUP) { const float gg = vA * rs, uu = vB * rs; s.out[m * s.ldo + 8 * (ct0 + j) + cg] = (bf16_t)f2bf(gg * sigmoidf_(gg) * uu); }
                  else { const unsigned xw = *(const unsigned*)(s.x2b + m * DM + col), pw = *(const unsigned*)(s.pp + m * DM + col);
                      vA = bflo(xw) + sigmoidf_(vA * rs) * bflo(pw); vB = bfhi(xw) + sigmoidf_(vB * rs) * bfhi(pw); *(unsigned*)(s.out + m * DM + col) = pk2(vA, vB); q += vA * vA + vB * vB; } }
              if (KIND == SK_RESID_F32 || KIND == SK_RESID_INPLACE || KIND == SK_PLE) { q = row8_sum(q); if (cg == 0) atomicAdd(s.ssout + m, q); } }
            __syncthreads();
        }
    }
}

struct Args { const float* in[31]; float* out; unsigned char* ws; int ph_lo, ph_hi; };
enum { I_XP = 0, I_XS, I_SWKV, I_SSHIFT, I_CK, I_CV, I_PP, I_PS, I_NMIX, I_WIN, I_MU, I_W0, I_W2, I_A0, I_A2, I_G2, I_KK, I_KA, I_RK, I_LNW, I_LNB, I_SINK, I_WOUT, I_NFFN, I_WGATE, I_WUP, I_WDOWN, I_NPLE, I_PGATE, I_PPROJ, I_FNORM };

__device__ __forceinline__ void tr_item(const float* W, int K, int N, bf16_t* WT, const float* gain, int mode, LAS unsigned char* scr, int item, int lane) {
    const int nblk = N / 64, kb = item / nblk, nb = item % nblk, k0 = 64 * kb, n0 = 64 * nb, r = lane >> 4, c4 = (lane & 15) * 4;
    const float* src = W + (size_t)(k0 + 16 * r) * N + n0 + c4;
    f32x4 v[16];
#pragma unroll
    for (int i = 0; i < 16; ++i) v[i] = *(const f32x4*)(src + (size_t)i * N);
    if (gain) {
#pragma unroll
        for (int i = 0; i < 16; ++i) v[i] = v[i] * gain[k0 + 16 * r + i]; }
#pragma unroll
    for (int jj = 0; jj < 4; ++jj) { u32x4 lo, hi;
        lo.x = cvt_pk_bf16(v[0][jj], v[1][jj]); lo.y = cvt_pk_bf16(v[2][jj], v[3][jj]); lo.z = cvt_pk_bf16(v[4][jj], v[5][jj]); lo.w = cvt_pk_bf16(v[6][jj], v[7][jj]);
        hi.x = cvt_pk_bf16(v[8][jj], v[9][jj]); hi.y = cvt_pk_bf16(v[10][jj], v[11][jj]); hi.z = cvt_pk_bf16(v[12][jj], v[13][jj]); hi.w = cvt_pk_bf16(v[14][jj], v[15][jj]);
        *(LAS u32x4*)(scr + (c4 + jj) * 144 + 32 * r) = lo; *(LAS u32x4*)(scr + (c4 + jj) * 144 + 32 * r + 16) = hi; }
    LDS_WAIT(); asm volatile("" ::: "memory");
#pragma unroll
    for (int q = 0; q < 8; ++q) { const int n = (lane >> 3) + 8 * q, ch = lane & 7, nn = n0 + n; const u32x4 o = *(const LAS u32x4*)(scr + n * 144 + ch * 16);
        const int row = mode == 0 ? nn : (2 * nn - (nn & 3) + (mode == 2 ? 4 : 0));
        *(u32x4*)(WT + (size_t)row * K + k0 + 8 * ch) = o; }
    LDS_WAIT(); asm volatile("" ::: "memory");
}
__device__ __forceinline__ void convert_jobs(const Args& a, LAS unsigned char* lds, int j0, int j1, int w, int nw) {
    const int lane = threadIdx.x & 63, wave = __builtin_amdgcn_readfirstlane(threadIdx.x >> 6);
    LAS unsigned char* scr = lds + wave * 16384; unsigned char* ws = a.ws;
    for (int j = j0; j < j1; ++j) {
        const float* W; int K, N, mode = 0; bf16_t* WT; const float* gain = nullptr;
        switch (j) {
            case 0: W = a.in[I_WIN]; K = DM; N = PROJ; WT = (bf16_t*)(ws + WS_WIN); break;
            case 1: W = a.in[I_WOUT]; K = DM; N = DM; WT = (bf16_t*)(ws + WS_WOUT); break;
            case 2: W = a.in[I_WGATE]; K = DM; N = DFF; WT = (bf16_t*)(ws + WS_WGU); gain = a.in[I_NFFN]; mode = 1; break;
            case 3: W = a.in[I_WUP]; K = DM; N = DFF; WT = (bf16_t*)(ws + WS_WGU); gain = a.in[I_NFFN]; mode = 2; break;
            case 4: W = a.in[I_WDOWN]; K = DFF; N = DM; WT = (bf16_t*)(ws + WS_WD); break;
            case 5: W = a.in[I_PGATE]; K = DM; N = DM; WT = (bf16_t*)(ws + WS_WPG); gain = a.in[I_NPLE]; break;
            default: W = a.in[I_PPROJ]; K = PLE; N = DM; WT = (bf16_t*)(ws + WS_WPP); break;
        }
        const int nitems = (K / 64) * (N / 64);
        for (int it = w; it < nitems; it += nw) tr_item(W, K, N, WT, gain, mode, scr, it, lane);
    }
}
__device__ __forceinline__ void tail_convert(const Args& a, LAS unsigned char* lds, int nwg, int G, int j0, int j1) {
    const int rem = nwg % G, c = (int)blockIdx.x, wave = __builtin_amdgcn_readfirstlane(threadIdx.x >> 6);
    if (rem == 0) { convert_jobs(a, lds, j0, j1, c * 8 + wave, G * 8); return; }
    if (c >= rem) convert_jobs(a, lds, j0, j1, (c - rem) * 8 + wave, (G - rem) * 8);
}
__device__ __forceinline__ void p0_prologue(const Args& a, LAS unsigned char* lds, int G) {
    const int tid = threadIdx.x, lane = tid & 63, wave = __builtin_amdgcn_readfirstlane(tid >> 6);
    const int gw = blockIdx.x * 8 + wave, NGW = G * 8;
    unsigned char* ws = a.ws;
    convert_jobs(a, lds, 0, 1, gw, NGW);
    const int gt = blockIdx.x * 512 + tid, NGT = G * 512;
    { u32x4* zp = (u32x4*)((bf16_t*)(ws + WS_WIN) + (size_t)PROJ * DM); for (int i = gt; i < (ZP - PROJ) * DM / 8; i += NGT) zp[i] = (u32x4){0u, 0u, 0u, 0u}; }
    { bf16_t* wl = (bf16_t*)(ws + WS_WLORA);
      for (int i = gt; i < 3 * 32 * 1024; i += NGT) { const int which = i / (32 * 1024), rem = i % (32 * 1024), kg = rem / 1024, n = rem % 1024;
          const int kw = which == 2 ? 256 : 96; const float* W = which == 0 ? a.in[I_W2] : (which == 1 ? a.in[I_A2] : a.in[I_G2]);
          float v[8];
#pragma unroll
          for (int jx = 0; jx < 8; ++jx) { const int k = 8 * kg + jx; v[jx] = k < kw ? W[(size_t)k * 1024 + n] : 0.f; }
          u32x4 w; w.x = pk2(v[0], v[1]); w.y = pk2(v[2], v[3]); w.z = pk2(v[4], v[5]); w.w = pk2(v[6], v[7]);
          *(u32x4*)(wl + ((size_t)which * 1024 + n) * 256 + 8 * kg) = w; } }
    { float* s1 = (float*)(ws + WS_SS1); float* s2 = (float*)(ws + WS_SS2); float* s3 = (float*)(ws + WS_SS3); for (int i = gt; i < MP; i += NGT) { s1[i] = 0.f; s2[i] = 0.f; s3[i] = 0.f; } }
    { bf16_t* hb = (bf16_t*)(ws + WS_HB); const float* gmix = a.in[I_NMIX];
      for (int m = gw; m < MP; m += NGW) {
          u32x2* o = (u32x2*)(hb + (size_t)m * DM) + lane;
          if (m >= MTOK) { for (int j = 0; j < 8; ++j) o[64 * j] = (u32x2){0u, 0u}; continue; }
          const f32x4* xr = (const f32x4*)(m < MPROMPT ? a.in[I_XP] + (size_t)m * DM : a.in[I_XS] + (size_t)(m - MPROMPT) * DM) + lane;
          f32x4 v[8]; float s = 0.f;
#pragma unroll
          for (int j = 0; j < 8; ++j) { v[j] = __builtin_nontemporal_load(xr + 64 * j); s += (v[j].x * v[j].x + v[j].y * v[j].y) + (v[j].z * v[j].z + v[j].w * v[j].w); }
          const float rs = rsqrtf(wave_sum(s) * (1.f / DM) + EPS);
#pragma unroll
          for (int j = 0; j < 8; ++j) { const f32x4 gg = ((const f32x4*)gmix)[lane + 64 * j]; u32x2 w; w.x = pk2(v[j].x * rs * gg.x, v[j].y * rs * gg.y); w.y = pk2(v[j].z * rs * gg.z, v[j].w * rs * gg.w); o[64 * j] = w; }
      } }
}

__device__ __forceinline__ void p2_lora_prep(const Args& a, int G) {
    const int tid = threadIdx.x, lane = tid & 63, wave = tid >> 6, gw = blockIdx.x * 8 + wave, NGW = G * 8;
    const bf16_t* z = (const bf16_t*)(a.ws + WS_Z); bf16_t* al = (bf16_t*)(a.ws + WS_MIX); const float* mu = a.in[I_MU]; const float* sshift = a.in[I_SSHIFT]; float* kn = (float*)(a.ws + WS_RKR);
    for (int m = gw; m < MP; m += NGW) {
        bf16_t* orow = al + (size_t)m * 768;
        const bool live = m < MTOK;
        const bool has_prev = m < MPROMPT && (m % SEQ) != 0;
#pragma unroll
        for (int pass = 0; pass < 2; ++pass) { const int gidx = lane + 64 * pass;
            if (gidx < 112) { const int zc = ZXW + 4 * gidx; const int seg = gidx < 24 ? 0 : (gidx < 48 ? 1 : 2); const int oc = seg == 0 ? 4 * gidx : (seg == 1 ? 256 + 4 * (gidx - 24) : 512 + 4 * (gidx - 48));
                f32x4 o = {0.f, 0.f, 0.f, 0.f};
                if (live) { const u32x2 zw = *(const u32x2*)(z + (size_t)m * ZP + zc); const f32x4 cur = {bflo(zw.x), bfhi(zw.x), bflo(zw.y), bfhi(zw.y)}; f32x4 prev = {0.f, 0.f, 0.f, 0.f};
                    if (has_prev) { const u32x2 pw = *(const u32x2*)(z + (size_t)(m - 1) * ZP + zc); prev = (f32x4){bflo(pw.x), bfhi(pw.x), bflo(pw.y), bfhi(pw.y)}; }
                    else if (m >= MPROMPT) prev = *(const f32x4*)(sshift + (size_t)(m - MPROMPT) * RWKV_PROJ + zc);
                    const f32x4 xs = cur + (prev - cur) * *(const f32x4*)(mu + zc);
#pragma unroll
                    for (int e = 0; e < 4; ++e) { if (seg == 0) { const float t = __expf(2.f * xs[e]); o[e] = 1.f - 2.f * __builtin_amdgcn_rcpf(t + 1.f); } else if (seg == 1) o[e] = xs[e]; else o[e] = sigmoidf_(xs[e]); } }
                u32x2 w; w.x = pk2(o[0], o[1]); w.y = pk2(o[2], o[3]); *(u32x2*)(orow + oc) = w; } }
        if (lane < 40) { const int oc = lane < 20 ? 96 + 8 * lane : 352 + 8 * (lane - 20); *(u32x4*)(orow + oc) = (u32x4){0u, 0u, 0u, 0u}; }
        if (live) {
#pragma unroll
        for (int hg = 0; hg < 4; ++hg) { const int head = hg * 4 + (lane >> 4), j = head * 64 + (lane & 15) * 4;
            const u32x2 zc = *(const u32x2*)(z + (size_t)m * ZP + 1024 + j); const f32x4 kc = {bflo(zc.x), bfhi(zc.x), bflo(zc.y), bfhi(zc.y)};
            f32x4 pk = {0.f, 0.f, 0.f, 0.f};
            if (has_prev) { const u32x2 zp = *(const u32x2*)(z + (size_t)(m - 1) * ZP + 1024 + j); pk = (f32x4){bflo(zp.x), bfhi(zp.x), bflo(zp.y), bfhi(zp.y)}; }
            else if (m >= MPROMPT) pk = *(const f32x4*)(sshift + (size_t)(m - MPROMPT) * RWKV_PROJ + 1024 + j);
            const f32x4 k = (kc + (pk - kc) * *(const f32x4*)(mu + 1024 + j)) * *(const f32x4*)(a.in[I_KK] + j);
            const float ss = row16_sum((k[0] * k[0] + k[1] * k[1]) + (k[2] * k[2] + k[3] * k[3]));
            if ((lane & 15) == 0) kn[(size_t)m * 16 + head] = rsqrtf(fmaxf(ss, 1e-24f)); } }
    }
}

constexpr int AL_STRIDE = 912;
template <int P> __device__ __forceinline__ void lora_epi(const Args& a, const f32x4 (&acc)[4][4], size_t m0, int ntile0, int c16, int kq) {
    bf16_t* out = (bf16_t*)(a.ws + WS_LORA);
#pragma unroll
    for (int i = 0; i < 4; ++i) { const int n0 = (ntile0 + i) * 16 + 4 * kq;
#pragma unroll
        for (int tt = 0; tt < 4; ++tt) { f32x4 v = acc[i][tt];
            if (P < 2) {
#pragma unroll
                for (int e = 0; e < 4; ++e) v[e] = (P == 0 ? -0.87503642f : 1.f) * sigmoidf_(v[e]); }
            u32x2 w; w.x = pk2(v[0], v[1]); w.y = pk2(v[2], v[3]);
            *(u32x2*)(out + (m0 + tt * 16 + c16) * 3072 + P * 1024 + n0) = w; } }
}
constexpr int LORA_D = 4, LORA_BIAS_OFF = 64 * AL_STRIDE;
__host__ __device__ constexpr int lora_step_p(int s) { return (s % 14) < 3 ? 0 : ((s % 14) < 6 ? 1 : 2); }
__host__ __device__ constexpr int lora_step_ks(int s) { return (s % 14) < 3 ? (s % 14) : ((s % 14) < 6 ? (s % 14) - 3 : (s % 14) - 6); }
typedef int i32x4_t __attribute__((ext_vector_type(4)));
template <int S> __device__ __forceinline__ void lora_load_step(bf16x8 (&ring)[LORA_D][4], const bf16_t* wbase) {
    const __amdgpu_buffer_rsrc_t wres = __builtin_amdgcn_make_buffer_rsrc((void*)wbase, 0, 0x7fffffff, 0x00020000);
    constexpr int off = ((lora_step_p(S) * 1024 + (S / 14) * 64) * 256 + 32 * lora_step_ks(S)) * 2;
    const int lane = (int)(threadIdx.x & 63), wave = __builtin_amdgcn_readfirstlane((int)(threadIdx.x >> 6));
    const int voff = ((lane & 15) * 256 + 8 * (lane >> 4)) * 2, soff = wave * (128 * 256 * 2) + off;
#pragma unroll
    for (int i = 0; i < 4; ++i) ring[S % LORA_D][i] = __builtin_bit_cast(bf16x8, __builtin_amdgcn_raw_buffer_load_b128(wres, voff, soff + i * 8192, 0));
}
template <int S> struct LoraSteps {
    static __device__ __forceinline__ void run(const Args& a, const LAS unsigned char* albase, const bf16_t* wbase, bf16x8 (&ring)[LORA_D][4], f32x4 (&acc)[4][4], size_t m0, int wave, int c16, int kq) {
        constexpr int P = lora_step_p(S), ks = lora_step_ks(S), kcol = (P == 0 ? 0 : (P == 1 ? 96 : 192)) + 32 * ks;
        if constexpr (ks == 0) {
#pragma unroll
            for (int i = 0; i < 4; ++i) { f32x4 b0 = {0.f, 0.f, 0.f, 0.f};
                if constexpr (P < 2) b0 = *(const LAS f32x4*)(albase - (c16 * AL_STRIDE + 16 * kq) + LORA_BIAS_OFF + (P * 1024 + (wave * 8 + (S / 14) * 4 + i) * 16 + 4 * kq) * 4);
#pragma unroll
                for (int tt = 0; tt < 4; ++tt) { acc[i][tt] = b0; asm volatile("" : "+v"(acc[i][tt])); } } }
#pragma unroll
        for (int tt = 0; tt < 4; ++tt) { const bf16x8 av = *(const LAS bf16x8*)(albase + tt * 16 * AL_STRIDE + kcol * 2);
#pragma unroll
            for (int i = 0; i < 4; ++i) acc[i][tt] = __builtin_amdgcn_mfma_f32_16x16x32_bf16(ring[S % LORA_D][i], av, acc[i][tt], 0, 0, 0); }
        if constexpr (S + LORA_D < 28) lora_load_step<S + LORA_D>(ring, wbase);
        const int nt0 = wave * 8 + (S / 14) * 4;
        if constexpr (S % 14 == 2) lora_epi<0>(a, acc, m0, nt0, c16, kq);
        if constexpr (S % 14 == 5) lora_epi<1>(a, acc, m0, nt0, c16, kq);
        if constexpr (S % 14 == 13) lora_epi<2>(a, acc, m0, nt0, c16, kq);
        if constexpr (S + 1 < 28) LoraSteps<S + 1>::run(a, albase, wbase, ring, acc, m0, wave, c16, kq);
    }
};
__device__ __forceinline__ void lora_mfma_unit(const Args& a, LAS unsigned char* lds, size_t m0, int lane) {
    const int wave = __builtin_amdgcn_readfirstlane(threadIdx.x >> 6), c16 = lane & 15, kq = lane >> 4;
    const bf16_t* wbase = (const bf16_t*)(a.ws + WS_WLORA);
    const LAS unsigned char* albase = lds + c16 * AL_STRIDE + 16 * kq;
    bf16x8 ring[LORA_D][4];
    f32x4 acc[4][4];
    lora_load_step<0>(ring, wbase); lora_load_step<1>(ring, wbase); lora_load_step<2>(ring, wbase); lora_load_step<3>(ring, wbase);
    LoraSteps<0>::run(a, albase, wbase, ring, acc, m0, wave, c16, kq);
}
template <int P> __device__ __forceinline__ void lora_sample_tile(const Args& a, LAS unsigned char* lds, size_t m0, int ntile) {
    constexpr int NKS = P == 2 ? 8 : 3, KCOL0 = P == 0 ? 0 : (P == 1 ? 96 : 192);
    const int lane = threadIdx.x & 63, c16 = lane & 15, kq = lane >> 4;
    const bf16_t* wl = (const bf16_t*)(a.ws + WS_WLORA) + ((size_t)P * 1024 + ntile * 16 + c16) * 256 + 8 * kq;
    bf16x8 b[NKS];
#pragma unroll
    for (int ks = 0; ks < NKS; ++ks) b[ks] = *(const bf16x8*)(wl + 32 * ks);
    f32x4 acc = {0.f, 0.f, 0.f, 0.f}; asm volatile("" : "+v"(acc));
#pragma unroll
    for (int ks = 0; ks < NKS; ++ks) { const bf16x8 av = *(const LAS bf16x8*)(lds + c16 * AL_STRIDE + (KCOL0 + 32 * ks + 8 * kq) * 2); acc = __builtin_amdgcn_mfma_f32_16x16x32_bf16(b[ks], av, acc, 0, 0, 0); }
    const int n0 = ntile * 16 + 4 * kq;
    f32x4 bias = {0.f, 0.f, 0.f, 0.f}; if (P < 2) bias = *(const LAS f32x4*)(lds + LORA_BIAS_OFF + (P * 1024 + n0) * 4);
    f32x4 v = acc + bias;
    if (P < 2) {
#pragma unroll
        for (int e = 0; e < 4; ++e) v[e] = (P == 0 ? -0.87503642f : 1.f) * sigmoidf_(v[e]); }
    u32x2 w; w.x = pk2(v[0], v[1]); w.y = pk2(v[2], v[3]);
    *(u32x2*)((bf16_t*)(a.ws + WS_LORA) + (m0 + c16) * 3072 + P * 1024 + n0) = w;
}
template <int NTW> __device__ __forceinline__ void knorm_tokens(const Args& a, size_t m, int lane) {
    const bf16_t* z = (const bf16_t*)(a.ws + WS_Z); const float* mu = a.in[I_MU]; const float* sshift = a.in[I_SSHIFT]; float* kn = (float*)(a.ws + WS_RKR);
    u32x2 zk[NTW + 1][4];
#pragma unroll
    for (int hg = 0; hg < 4; ++hg) { const int j = (hg * 4 + (lane >> 4)) * 64 + (lane & 15) * 4;
        zk[0][hg] = (u32x2){0u, 0u}; if (m < MPROMPT && (m % SEQ) != 0) zk[0][hg] = *(const u32x2*)(z + (m - 1) * ZP + 1024 + j);
#pragma unroll
        for (int t = 0; t < NTW; ++t) zk[t + 1][hg] = *(const u32x2*)(z + (m + t) * ZP + 1024 + j); }
#pragma unroll
    for (int hg = 0; hg < 4; ++hg) { const int head = hg * 4 + (lane >> 4), j = head * 64 + (lane & 15) * 4;
        const f32x4 muk = *(const f32x4*)(mu + 1024 + j), kkc = *(const f32x4*)(a.in[I_KK] + j);
#pragma unroll
        for (int t = 0; t < NTW; ++t) { const f32x4 kc = bf4(zk[t + 1][hg]);
            f32x4 pk = bf4(zk[t][hg]); if (m + t >= MPROMPT) pk = *(const f32x4*)(sshift + (m + t - MPROMPT) * RWKV_PROJ + 1024 + j);
            const f32x4 k = (kc + (pk - kc) * muk) * kkc;
            const float ss = row16_sum((k[0] * k[0] + k[1] * k[1]) + (k[2] * k[2] + k[3] * k[3]));
            if ((lane & 15) == 0) kn[(m + t) * 16 + head] = rsqrtf(fmaxf(ss, 1e-24f)); } }
}
__device__ __forceinline__ void p2_lora_fused(const Args& a, LAS unsigned char* lds, int G) {
    const int tid = threadIdx.x, lane = tid & 63, wave = __builtin_amdgcn_readfirstlane(tid >> 6);
    const bf16_t* z = (const bf16_t*)(a.ws + WS_Z); const float* mu = a.in[I_MU]; const float* sshift = a.in[I_SSHIFT];
    { const f32x4 bv = tid < 256 ? ((const f32x4*)a.in[I_W0])[tid] : ((const f32x4*)a.in[I_A0])[tid - 256]; *(LAS f32x4*)(lds + LORA_BIAS_OFF + tid * 16) = bv; }
    for (int u = blockIdx.x; u < 512; u += G) {
        const bool single = u >= 256;
        const size_t m0 = single ? (size_t)MPROMPT + 16 * ((u - 256) >> 5) : (size_t)64 * u; const int ntok = single ? 16 : 64;
        { int g8 = tid & 7; asm volatile("" : "+v"(g8));
          const int t = tid >> 3; const size_t m = m0 + t; const bool act = t < ntok;
          const bool from_state = m >= MPROMPT, from_prev = !from_state && (m % SEQ) != 0;
#pragma unroll
          for (int jh = 0; jh < 2; ++jh) { asm volatile("" ::: "memory");
          u32x2 zc_[7], zp_[7]; f32x4 sp_[7];
#pragma unroll
          for (int jj = 0; jj < 7; ++jj) { const int zc = ZXW + 4 * (g8 + 8 * (jh * 7 + jj)); zc_[jj] = (u32x2){0u, 0u}; zp_[jj] = (u32x2){0u, 0u}; sp_[jj] = (f32x4){0.f, 0.f, 0.f, 0.f};
              if (act) { zc_[jj] = *(const u32x2*)(z + m * ZP + zc); if (from_prev) zp_[jj] = *(const u32x2*)(z + (m - 1) * ZP + zc); if (from_state) sp_[jj] = *(const f32x4*)(sshift + (m - MPROMPT) * RWKV_PROJ + zc); } }
          if (act) {
#pragma unroll
          for (int jj = 0; jj < 7; ++jj) { const int gi = g8 + 8 * (jh * 7 + jj), zc = ZXW + 4 * gi;
              const f32x4 cur = bf4(zc_[jj]);
              const f32x4 prev = from_state ? sp_[jj] : bf4(zp_[jj]);
              const f32x4 xs = cur + (prev - cur) * *(const f32x4*)(mu + zc);
              f32x4 o;
#pragma unroll
              for (int e = 0; e < 4; ++e) { const int jg = jh * 7 + jj;
                  if (jg < 3) { const float tq = __expf(2.f * xs[e]); o[e] = 1.f - 2.f * __builtin_amdgcn_rcpf(tq + 1.f); } else if (jg < 6) o[e] = xs[e]; else o[e] = sigmoidf_(xs[e]); }
              u32x2 w; w.x = pk2(o[0], o[1]); w.y = pk2(o[2], o[3]); *(LAS u32x2*)(lds + t * AL_STRIDE + gi * 8) = w; } } } }
        int lane_ = lane; asm volatile("" : "+v"(lane_));
        if (!single) knorm_tokens<8>(a, m0 + 8 * wave, lane_); else if (((u - 256) & 31) == 0) knorm_tokens<2>(a, m0 + 2 * wave, lane_);
        __syncthreads();
        if (!single) lora_mfma_unit(a, lds, m0, lane_);
        else { const int ns = (u - 256) & 31, nt = 2 * ns + (wave & 1);
            if (wave < 2) lora_sample_tile<0>(a, lds, m0, nt); else if (wave < 4) lora_sample_tile<1>(a, lds, m0, nt); else if (wave < 6) lora_sample_tile<2>(a, lds, m0, nt); }
        __syncthreads();
    }
}

constexpr int TC = 32;
constexpr int OP_TOK = 6 * 64;
struct RwkvConst { float mu_r, mu_k, mu_v, kkc, kac, kac1, rkc; };
__device__ __forceinline__ void rwkv_prep_token(LAS float* op, int lane, const RwkvConst& c, float zr, float zk, float zv, float pr, float pk, float pv, float e, float av, float kn, float* bon) {
    const float r = zr + (pr - zr) * c.mu_r, k = zk + (pk - zk) * c.mu_k, v = zv + (pv - zv) * c.mu_v;
    const float d = __builtin_amdgcn_exp2f(e);
    const float kk = k * c.kkc * kn;
    const float kh = k * __builtin_fmaf(av, c.kac, c.kac1);
    op[lane] = kk; op[64 + lane] = d; op[128 + lane] = -kk * av; op[192 + lane] = kh; op[256 + lane] = r; op[320 + lane] = v;
    if (bon) {
        float t = row16_sum(r * kh * c.rkc);
        t += __int_as_float(__builtin_amdgcn_update_dpp(0, __float_as_int(t), 0x142, 0xa, 0xf, false));
        t += __int_as_float(__builtin_amdgcn_update_dpp(0, __float_as_int(t), 0x143, 0xc, 0xf, false));
        if (lane == 63) *bon = t; }
}
__device__ __forceinline__ RwkvConst rwkv_consts(const Args& a, int h, int lane) {
    const int j = h * 64 + lane; RwkvConst c;
    c.mu_r = a.in[I_MU][j]; c.mu_k = a.in[I_MU][1024 + j]; c.mu_v = a.in[I_MU][2048 + j]; c.kkc = a.in[I_KK][j]; c.kac = a.in[I_KA][j]; c.kac1 = 1.f - c.kac; c.rkc = a.in[I_RK][j];
    return c;
}
struct StepOps { f32x4 kk, d, nb, kh, r; float vv; };
__device__ __forceinline__ StepOps rwkv_load_ops(const LAS float* op, int k0, int vrow) {
    StepOps o; o.kk = *(const LAS f32x4*)(op + k0); o.d = *(const LAS f32x4*)(op + 64 + k0); o.nb = *(const LAS f32x4*)(op + 128 + k0); o.kh = *(const LAS f32x4*)(op + 192 + k0); o.r = *(const LAS f32x4*)(op + 256 + k0); o.vv = op[320 + vrow]; return o;
}
__device__ __forceinline__ float rwkv_step_ops(f32x2& s01, f32x2& s23, const StepOps& o) {
    f32x2 t = s01 * o.kk.lo; t = __builtin_elementwise_fma(s23, o.kk.hi, t);
    const float dot = row16_sum(t.x + t.y);
    const f32x2 dd = {dot, dot}, vv = {o.vv, o.vv};
    s01 = s01 * o.d.lo; s23 = s23 * o.d.hi;
    s01 = __builtin_elementwise_fma(dd, o.nb.lo, s01); s23 = __builtin_elementwise_fma(dd, o.nb.hi, s23);
    s01 = __builtin_elementwise_fma(vv, o.kh.lo, s01); s23 = __builtin_elementwise_fma(vv, o.kh.hi, s23);
    f32x2 u = s01 * o.r.lo; u = __builtin_elementwise_fma(s23, o.r.hi, u);
    return row16_sum(u.x + u.y);
}
struct StepOps8 { f32x4 kk0, kk1, d0, d1, nb0, nb1, kh0, kh1, r0, r1; float vv; };
__device__ __forceinline__ StepOps8 rwkv_load_ops8(const LAS float* op, int k0, int vrow) {
    StepOps8 o; o.kk0 = *(const LAS f32x4*)(op + k0); o.kk1 = *(const LAS f32x4*)(op + k0 + 4); o.d0 = *(const LAS f32x4*)(op + 64 + k0); o.d1 = *(const LAS f32x4*)(op + 64 + k0 + 4);
    o.nb0 = *(const LAS f32x4*)(op + 128 + k0); o.nb1 = *(const LAS f32x4*)(op + 128 + k0 + 4); o.kh0 = *(const LAS f32x4*)(op + 192 + k0); o.kh1 = *(const LAS f32x4*)(op + 192 + k0 + 4);
    o.r0 = *(const LAS f32x4*)(op + 256 + k0); o.r1 = *(const LAS f32x4*)(op + 256 + k0 + 4); o.vv = op[320 + vrow]; return o;
}
__device__ __forceinline__ float rwkv_step_ops8(f32x2 (&s)[4], const StepOps8& o) {
    f32x2 t0 = s[0] * o.kk0.lo, t1 = s[2] * o.kk1.lo; t0 = __builtin_elementwise_fma(s[1], o.kk0.hi, t0); t1 = __builtin_elementwise_fma(s[3], o.kk1.hi, t1); t0 = t0 + t1;
    const float dot = row8_sum(t0.x + t0.y);
    const f32x2 dd = {dot, dot}, vv = {o.vv, o.vv};
    s[0] = s[0] * o.d0.lo; s[1] = s[1] * o.d0.hi; s[2] = s[2] * o.d1.lo; s[3] = s[3] * o.d1.hi;
    s[0] = __builtin_elementwise_fma(dd, o.nb0.lo, s[0]); s[1] = __builtin_elementwise_fma(dd, o.nb0.hi, s[1]); s[2] = __builtin_elementwise_fma(dd, o.nb1.lo, s[2]); s[3] = __builtin_elementwise_fma(dd, o.nb1.hi, s[3]);
    s[0] = __builtin_elementwise_fma(vv, o.kh0.lo, s[0]); s[1] = __builtin_elementwise_fma(vv, o.kh0.hi, s[1]); s[2] = __builtin_elementwise_fma(vv, o.kh1.lo, s[2]); s[3] = __builtin_elementwise_fma(vv, o.kh1.hi, s[3]);
    f32x2 u0 = s[0] * o.r0.lo, u1 = s[2] * o.r1.lo; u0 = __builtin_elementwise_fma(s[1], o.r0.hi, u0); u1 = __builtin_elementwise_fma(s[3], o.r1.hi, u1); u0 = u0 + u1;
    return row8_sum(u0.x + u0.y);
}
__device__ __forceinline__ void scan_prompt_item(const Args& a, LAS unsigned char* lds, int item) {
    const int chain = item >> 1, half = item & 1, b = chain >> 4, h = chain & 15;
    const int tid = threadIdx.x, lane = tid & 63, wave = __builtin_amdgcn_readfirstlane(tid >> 6);
    LAS float* OP = (LAS float*)lds;
    LAS float* YB = (LAS float*)(lds + 2 * TC * OP_TOK * 4);
    const bf16_t* z = (const bf16_t*)(a.ws + WS_Z); const bf16_t* lo = (const bf16_t*)(a.ws + WS_LORA);
    bf16_t* ybuf = (bf16_t*)(a.ws + WS_HB); const float* knp = (const float*)(a.ws + WS_RKR);
    const size_t mrow0 = (size_t)b * SEQ;
    constexpr int NCH = SEQ / TC;
    const RwkvConst c = rwkv_consts(a, h, lane);
    const int j = h * 64 + lane;
    constexpr int TPW = TC / 4, TP0 = TC / 8;
    unsigned short zr_[TPW + 1], zk_[TPW + 1], zv_[TPW + 1], e_[TPW], a_[TPW]; float kn_[TPW];
    const __amdgpu_buffer_rsrc_t zres = __builtin_amdgcn_make_buffer_rsrc((void*)z, 0, 0x7fffffff, 0x00020000), lres = __builtin_amdgcn_make_buffer_rsrc((void*)lo, 0, 0x7fffffff, 0x00020000);
    const int jo = j * 2;
#define SCAN_LOAD(tfirst, NT) do { const int t0_ = __builtin_amdgcn_readfirstlane(tfirst); const int zo_ = (int)((mrow0 + t0_) * (ZP * 2)), lo_ = (int)((mrow0 + t0_) * (3072 * 2)); \
        _Pragma("unroll") for (int i_ = 0; i_ < (NT); ++i_) { \
            zr_[i_ + 1] = __builtin_amdgcn_raw_buffer_load_b16(zres, jo, zo_ + i_ * (ZP * 2), 0); zk_[i_ + 1] = __builtin_amdgcn_raw_buffer_load_b16(zres, jo + 2048, zo_ + i_ * (ZP * 2), 0); zv_[i_ + 1] = __builtin_amdgcn_raw_buffer_load_b16(zres, jo, zo_ + i_ * (ZP * 2) + 4096, 0); \
            e_[i_] = __builtin_amdgcn_raw_buffer_load_b16(lres, jo, lo_ + i_ * (3072 * 2), 0); a_[i_] = __builtin_amdgcn_raw_buffer_load_b16(lres, jo + 2048, lo_ + i_ * (3072 * 2), 0); kn_[i_] = knp[(mrow0 + t0_ + i_) * 16 + h]; } \
        if (t0_ > 0) { zr_[0] = __builtin_amdgcn_raw_buffer_load_b16(zres, jo, zo_ - ZP * 2, 0); zk_[0] = __builtin_amdgcn_raw_buffer_load_b16(zres, jo + 2048, zo_ - ZP * 2, 0); zv_[0] = __builtin_amdgcn_raw_buffer_load_b16(zres, jo, zo_ - ZP * 2 + 4096, 0); } else { zr_[0] = 0; zk_[0] = 0; zv_[0] = 0; } } while (0)
#define SCAN_PREP(opbase, NT, tok0) do { _Pragma("unroll") for (int i_ = 0; i_ < (NT); ++i_) \
        rwkv_prep_token((opbase) + i_ * OP_TOK, lane, c, bf2f(zr_[i_ + 1]), bf2f(zk_[i_ + 1]), bf2f(zv_[i_ + 1]), bf2f(zr_[i_]), bf2f(zk_[i_]), bf2f(zv_[i_]), bf2f(e_[i_]), bf2f(a_[i_]), kn_[i_], half == 0 ? bonp + (mrow0 + (tok0) + i_) * 16 + h : nullptr); } while (0)
    float* bonp = (float*)(a.ws + WS_BON);
    SCAN_LOAD(TP0 * wave, TP0); SCAN_PREP(OP + TP0 * wave * OP_TOK, TP0, TP0 * wave);
    __syncthreads();
    const int vloc = (wave & 3) * 8 + (lane >> 3), vrow = half * 32 + vloc, k0 = (lane & 7) * 8, l8 = lane & 7;
    f32x2 s[4] = {{0.f, 0.f}, {0.f, 0.f}, {0.f, 0.f}, {0.f, 0.f}};
    for (int cc = 0; cc < NCH; ++cc) {
        const LAS float* opc = OP + (cc & 1) * TC * OP_TOK; LAS float* yb = YB + (cc & 1) * TC * 32;
        if (wave < 4) {
            StepOps8 cur = rwkv_load_ops8(opc, k0, vrow), nxt = cur; float yk[TC / 8];
#pragma unroll
            for (int q = 0; q < TC / 8; ++q) yk[q] = 0.f;
#pragma unroll
            for (int tt = 0; tt < TC; ++tt) { if (tt + 1 < TC) nxt = rwkv_load_ops8(opc + (tt + 1) * OP_TOK, k0, vrow); const float y = rwkv_step_ops8(s, cur);
                yk[tt >> 3] = (l8 == (tt & 7)) ? y : yk[tt >> 3]; cur = nxt; }
#pragma unroll
            for (int q = 0; q < TC / 8; ++q) yb[(l8 + 8 * q) * 32 + vloc] = yk[q];
        } else if (cc + 1 < NCH) {
            const int tf = (cc + 1) * TC + TPW * (wave - 4);
            SCAN_LOAD(tf, TPW); SCAN_PREP(OP + (((cc + 1) & 1) * TC + TPW * (wave - 4)) * OP_TOK, TPW, tf);
        }
        __syncthreads();
#pragma unroll
        for (int q = 0; q < TC / 32; ++q) { const int tt = (tid >> 4) + 32 * q, vp = (tid & 15) * 2; const f32x2 yv = *(const LAS f32x2*)(yb + tt * 32 + vp);
            *(unsigned*)(ybuf + (mrow0 + cc * TC + tt) * 1024 + h * 64 + half * 32 + vp) = pk2(yv.x, yv.y); }
    }
#undef SCAN_LOAD
#undef SCAN_PREP
    if (wave < 4) { float* so = a.out + O_WKVP + ((size_t)(b * 16 + h) * 64 + vrow) * 64 + k0; *(f32x4*)so = (f32x4){s[0].x, s[0].y, s[1].x, s[1].y}; *(f32x4*)(so + 4) = (f32x4){s[2].x, s[2].y, s[3].x, s[3].y}; }
    __syncthreads();
}
__device__ __forceinline__ void scan_sample_pair(const Args& a, LAS unsigned char* lds, int pair) {
    const int tid = threadIdx.x, lane = tid & 63, wave = __builtin_amdgcn_readfirstlane(tid >> 6);
    LAS float* op = (LAS float*)lds + wave * OP_TOK;
    const bf16_t* z = (const bf16_t*)(a.ws + WS_Z); const bf16_t* lo = (const bf16_t*)(a.ws + WS_LORA);
    bf16_t* ybuf = (bf16_t*)(a.ws + WS_HB); const float* knp = (const float*)(a.ws + WS_RKR);
    const int bs = pair >> 4, h = pair & 15, j = h * 64 + lane, k0 = (lane & 15) * 4;
    const size_t m = (size_t)MPROMPT + bs;
    const float* sh = a.in[I_SSHIFT] + (size_t)bs * RWKV_PROJ;
    const float* sin_ = a.in[I_SWKV] + (size_t)(bs * 16 + h) * 4096 + (lane >> 4) * 64 + k0; float* sout = a.out + O_WKVS + (size_t)(bs * 16 + h) * 4096 + (lane >> 4) * 64 + k0;
    f32x4 sv[16];
#pragma unroll
    for (int rg = 0; rg < 16; ++rg) sv[rg] = *(const f32x4*)(sin_ + rg * 256);
    const RwkvConst c = rwkv_consts(a, h, lane);
    const bf16_t* zr = z + m * ZP + j; const bf16_t* l0 = lo + m * 3072 + j;
    rwkv_prep_token(op, lane, c, bf2f(zr[0]), bf2f(zr[1024]), bf2f(zr[2048]), sh[j], sh[1024 + j], sh[2048 + j], bf2f(l0[0]), bf2f(l0[1024]), knp[m * 16 + h], (float*)(a.ws + WS_BON) + m * 16 + h);
    LDS_WAIT(); asm volatile("" ::: "memory");
#pragma unroll
    for (int rg = 0; rg < 16; ++rg) { const int row = rg * 4 + (lane >> 4);
        f32x2 s01 = sv[rg].lo, s23 = sv[rg].hi;
        const float y = rwkv_step_ops(s01, s23, rwkv_load_ops(op, k0, row));
        __builtin_nontemporal_store((f32x4){s01.x, s01.y, s23.x, s23.y}, (f32x4*)(sout + rg * 256));
        if ((lane & 15) == 0) ybuf[m * 1024 + h * 64 + row] = (bf16_t)f2bf(y); }
    LDS_WAIT(); asm volatile("" ::: "memory");
}

constexpr int AT_KS = 0, AT_VT = 32768, AT_VTS = 528;
__device__ __forceinline__ float bperm_f(unsigned addr, float v) { return __int_as_float(__builtin_amdgcn_ds_bpermute((int)addr, __float_as_int(v))); }
constexpr int AT_BUF = 66560;
__device__ __forceinline__ void attn_stage2(const Args& a, LAS unsigned char* lds, int u0, int u1) {
    const int tid = threadIdx.x; const bf16_t* z = (const bf16_t*)(a.ws + WS_Z);
    u32x4 kv[2][4], vv[2][4];
#pragma unroll
    for (int uu = 0; uu < 2; ++uu) { const int unit = uu ? u1 : u0, kvh = unit & 3, nb = (unit >> 2) & 15, b = unit >> 6; const long mk0 = (long)b * SEQ + nb * 128 - 128;
#pragma unroll
        for (int i = 0; i < 4; ++i) { const int ch = tid + 512 * i, key = ch >> 3, cc = ch & 7; kv[uu][i] = (u32x4){0u, 0u, 0u, 0u}; vv[uu][i] = (u32x4){0u, 0u, 0u, 0u};
            if (unit >= 0 && (nb > 0 || key >= 128)) { const bf16_t* zr = z + (size_t)(mk0 + key) * ZP + kvh * 64 + cc * 8; kv[uu][i] = *(const u32x4*)(zr + ZK); vv[uu][i] = *(const u32x4*)(zr + ZV); } } }
#pragma unroll
    for (int uu = 0; uu < 2; ++uu) { LAS unsigned char* lb = lds + uu * AT_BUF;
#pragma unroll
        for (int i = 0; i < 4; ++i) { const int ch = tid + 512 * i, key = ch >> 3, cc = ch & 7; const u32x4 w = vv[uu][i];
            *(LAS u32x4*)(lb + AT_KS + key * 128 + ((cc ^ (key & 7)) << 4)) = kv[uu][i];
            LAS bf16_t* vt = (LAS bf16_t*)(lb + AT_VT) + (cc * 8) * (AT_VTS / 2) + ((((key >> 3) ^ cc) << 3) | (key & 7));
            vt[0 * (AT_VTS / 2)] = (bf16_t)(w.x & 0xffff); vt[1 * (AT_VTS / 2)] = (bf16_t)(w.x >> 16); vt[2 * (AT_VTS / 2)] = (bf16_t)(w.y & 0xffff); vt[3 * (AT_VTS / 2)] = (bf16_t)(w.y >> 16);
            vt[4 * (AT_VTS / 2)] = (bf16_t)(w.z & 0xffff); vt[5 * (AT_VTS / 2)] = (bf16_t)(w.z >> 16); vt[6 * (AT_VTS / 2)] = (bf16_t)(w.w & 0xffff); vt[7 * (AT_VTS / 2)] = (bf16_t)(w.w >> 16); } }
}
struct AttnQ { bf16x8 q[4][2]; };
__device__ __forceinline__ AttnQ attn_load_q(const Args& a, int unit) {
    const int kvh = unit & 3, nb = (unit >> 2) & 15, b = unit >> 6, lane = threadIdx.x & 63, wave = __builtin_amdgcn_readfirstlane(threadIdx.x >> 6), c16 = lane & 15, g = lane >> 4;
    const bf16_t* z = (const bf16_t*)(a.ws + WS_Z); const long m0 = (long)b * SEQ + nb * 128; AttnQ r;
#pragma unroll
    for (int it = 0; it < 4; ++it) { const int G_ = wave * 4 + it, head_ = kvh * 4 + (G_ >> 3), i0_ = (G_ & 7) * 16;
        const bf16_t* qp = z + (size_t)(m0 + i0_ + c16) * ZP + ZQ + head_ * 64 + g * 8; r.q[it][0] = *(const bf16x8*)qp; r.q[it][1] = *(const bf16x8*)(qp + 32); }
    return r;
}
__device__ __forceinline__ void attn_compute(const Args& a, LAS unsigned char* lds, int unit, const AttnQ& Q) {
    const int kvh = unit & 3, nb = (unit >> 2) & 15, b = unit >> 6;
    const int tid = threadIdx.x, lane = tid & 63, wave = __builtin_amdgcn_readfirstlane(tid >> 6), c16 = lane & 15, g = lane >> 4;
    bf16_t* mix = (bf16_t*)(a.ws + WS_MIX);
    const long m0 = (long)b * SEQ + nb * 128;
    const unsigned bp16 = (unsigned)((lane ^ 16) << 2), bp32 = (unsigned)((lane ^ 32) << 2);
    constexpr float LOG2E = 1.44269504f, SC2 = 0.125f * 1.44269504f;
#pragma unroll
    for (int it = 0; it < 4; ++it) {
        const int G = wave * 4 + it, hq = G >> 3, q16 = G & 7, head = kvh * 4 + hq, i0 = q16 * 16;
        const float sl2 = exp2f(-0.5f * (float)(head + 1)) * LOG2E, sink2 = a.in[I_SINK][head] * LOG2E;
        f32x4 sc[9];
#pragma unroll
        for (int u = 0; u < 9; ++u) { const int key = 16 * (q16 + u) + c16; f32x4 acc = {0.f, 0.f, 0.f, 0.f};
#pragma unroll
            for (int ks = 0; ks < 2; ++ks) { const bf16x8 kf = *(const LAS bf16x8*)(lds + AT_KS + key * 128 + (((ks * 4 + g) ^ (key & 7)) << 4)); acc = __builtin_amdgcn_mfma_f32_16x16x32_bf16(kf, Q.q[it][ks], acc, 0, 0, 0); }
            sc[u] = acc; }
        float cr[4];
#pragma unroll
        for (int r = 0; r < 4; ++r) cr[r] = -sl2 * (float)(128 + c16 - 4 * g - r);
        float m = -3.0e38f;
#pragma unroll
        for (int u = 0; u < 9; ++u) { const float ct = sl2 * (float)(16 * u);
#pragma unroll
            for (int r = 0; r < 4; ++r) { float v = __builtin_fmaf(sc[u][r], SC2, cr[r]);
                if (u == 0) v = (c16 < 4 * g + r) ? v : -3.0e38f;
                if (u == 8) v = (c16 >= 4 * g + r) ? v : -3.0e38f;
                sc[u][r] = v; }
            if (nb == 0 && q16 + u < 8) {
#pragma unroll
                for (int r = 0; r < 4; ++r) sc[u][r] = -3.0e38f; }
            m = fmaxf(m, fmaxf(fmaxf(sc[u][0], sc[u][1]), fmaxf(sc[u][2], sc[u][3])) + ct); }
        m = fmaxf(m, bperm_f(bp16, m)); m = fmaxf(m, bperm_f(bp32, m));
        const float mx = fmaxf(m, sink2);
        float sum = 0.f;
#pragma unroll
        for (int u = 0; u < 9; ++u) { const float cu = sl2 * (float)(16 * u) - mx;
#pragma unroll
            for (int r = 0; r < 4; ++r) { const float p = __builtin_amdgcn_exp2f(sc[u][r] + cu); sc[u][r] = p; sum += p; } }
        sum += bperm_f(bp16, sum); sum += bperm_f(bp32, sum);
        const float inv = __builtin_amdgcn_rcpf(sum + __builtin_amdgcn_exp2f(sink2 - mx));
        f32x4 o[4];
#pragma unroll
        for (int dt = 0; dt < 4; ++dt) o[dt] = (f32x4){0.f, 0.f, 0.f, 0.f};
#pragma unroll
        for (int kt = 0; kt < 5; ++kt) { const int u0 = 2 * kt, u1 = 2 * kt + 1;
            u32x4 pw; pw.x = pk2(sc[u0][0], sc[u0][1]); pw.y = pk2(sc[u0][2], sc[u0][3]);
            if (u1 < 9) { pw.z = pk2(sc[u1 < 9 ? u1 : 0][0], sc[u1 < 9 ? u1 : 0][1]); pw.w = pk2(sc[u1 < 9 ? u1 : 0][2], sc[u1 < 9 ? u1 : 0][3]); } else { pw.z = 0u; pw.w = 0u; }
            const bf16x8 pf = __builtin_bit_cast(bf16x8, pw);
            const int grp0 = 2 * (q16 + u0) + (g >> 1), grp1 = u1 < 9 ? grp0 + 2 : grp0;
#pragma unroll
            for (int dt = 0; dt < 4; ++dt) { const int row = 16 * dt + c16, sw = (2 * dt + (c16 >> 3)) & 7; const LAS unsigned char* vr = lds + AT_VT + row * AT_VTS + (g & 1) * 8;
                const u32x2 lo = *(const LAS u32x2*)(vr + ((grp0 ^ sw) << 4)), hi = *(const LAS u32x2*)(vr + ((grp1 ^ sw) << 4));
                const u32x4 vw = {lo.x, lo.y, hi.x, hi.y};
                o[dt] = __builtin_amdgcn_mfma_f32_16x16x32_bf16(__builtin_bit_cast(bf16x8, vw), pf, o[dt], 0, 0, 0); } }
        { bf16_t* orow = mix + (size_t)(m0 + i0 + c16) * DM + 1024 + head * 64 + 4 * g;
#pragma unroll
          for (int dt = 0; dt < 4; ++dt) { const f32x4 on = o[dt] * inv; u32x2 w; w.x = pk2(on[0], on[1]); w.y = pk2(on[2], on[3]); *(u32x2*)(orow + 16 * dt) = w; } }
    }
}
__device__ __forceinline__ void attn_sample_unit(const Args& a, LAS float* scl  , int unit, int lane) {
    const int kvh = unit & 3, bs = unit >> 2, ksub = lane >> 4, dq = (lane & 15) * 4;
    const bf16_t* z = (const bf16_t*)(a.ws + WS_Z); bf16_t* mix = (bf16_t*)(a.ws + WS_MIX);
    const size_t m = (size_t)MPROMPT + bs;
    const float* ck = a.in[I_CK] + ((size_t)bs * 128 * 4 + kvh) * 64 + dq; const float* cv = a.in[I_CV] + ((size_t)bs * 128 * 4 + kvh) * 64 + dq;
    float* ko = a.out + O_KS + ((size_t)bs * 128 * 4 + kvh) * 64 + dq; float* vo = a.out + O_VS + ((size_t)bs * 128 * 4 + kvh) * 64 + dq;
    f32x4 qv[4]; float slope[4], sink[4];
#pragma unroll
    for (int gq = 0; gq < 4; ++gq) { const int head = kvh * 4 + gq; const u32x2 w = *(const u32x2*)(z + m * ZP + ZQ + head * 64 + dq); qv[gq] = (f32x4){bflo(w.x), bfhi(w.x), bflo(w.y), bfhi(w.y)};
        slope[gq] = exp2f(-0.5f * (float)(head + 1)); sink[gq] = a.in[I_SINK][head]; }
    f32x4 knew, vnew;
    { const u32x2 w = *(const u32x2*)(z + m * ZP + ZK + kvh * 64 + dq); knew = (f32x4){bflo(w.x), bfhi(w.x), bflo(w.y), bfhi(w.y)};
      const u32x2 w2 = *(const u32x2*)(z + m * ZP + ZV + kvh * 64 + dq); vnew = (f32x4){bflo(w2.x), bfhi(w2.x), bflo(w2.y), bfhi(w2.y)}; }
#pragma unroll 1
    for (int hb = 0; hb < 4; ++hb) { f32x4 kr[8]; asm volatile("" ::: "memory");
#pragma unroll
        for (int i = 0; i < 8; ++i) { const int s = (hb * 8 + i) * 4 + ksub; const int sr = s < 127 ? s + 1 : 127; kr[i] = *(const f32x4*)(ck + (size_t)sr * 256); }
#pragma unroll
        for (int i = 0; i < 8; ++i) { const int s = (hb * 8 + i) * 4 + ksub; const f32x4 kv = s < 127 ? kr[i] : knew;
            __builtin_nontemporal_store(kv, (f32x4*)(ko + (size_t)s * 256));
#pragma unroll
            for (int gq = 0; gq < 4; ++gq) { const float p = row16_sum((qv[gq][0] * kv[0] + qv[gq][1] * kv[1]) + (qv[gq][2] * kv[2] + qv[gq][3] * kv[3]));
                if ((lane & 15) == 0) scl[gq * 128 + s] = p * 0.125f - slope[gq] * (float)(127 - s); } } }
    LDS_WAIT(); asm volatile("" ::: "memory");
#pragma unroll
    for (int gq = 0; gq < 4; ++gq) { const float v0 = scl[gq * 128 + lane], v1 = scl[gq * 128 + 64 + lane]; const float mxv = fmaxf(wave_max(fmaxf(v0, v1)), sink[gq]);
        const float p0 = __expf(v0 - mxv), p1 = __expf(v1 - mxv); const float inv = __builtin_amdgcn_rcpf(wave_sum(p0 + p1) + __expf(sink[gq] - mxv));
        scl[gq * 128 + lane] = p0 * inv; scl[gq * 128 + 64 + lane] = p1 * inv; }
    LDS_WAIT(); asm volatile("" ::: "memory");
    f32x4 o[4];
#pragma unroll
    for (int gq = 0; gq < 4; ++gq) o[gq] = (f32x4){0.f, 0.f, 0.f, 0.f};
#pragma unroll 1
    for (int hb = 0; hb < 4; ++hb) { f32x4 vr[8]; asm volatile("" ::: "memory");
#pragma unroll
        for (int i = 0; i < 8; ++i) { const int s = (hb * 8 + i) * 4 + ksub; const int sr = s < 127 ? s + 1 : 127; vr[i] = *(const f32x4*)(cv + (size_t)sr * 256); }
#pragma unroll
        for (int i = 0; i < 8; ++i) { const int s = (hb * 8 + i) * 4 + ksub; const f32x4 vv = s < 127 ? vr[i] : vnew;
            __builtin_nontemporal_store(vv, (f32x4*)(vo + (size_t)s * 256));
#pragma unroll
            for (int gq = 0; gq < 4; ++gq) o[gq] += scl[gq * 128 + s] * vv; } }
#pragma unroll
    for (int gq = 0; gq < 4; ++gq) {
#pragma unroll
        for (int j = 0; j < 4; ++j) { float t = o[gq][j]; t += __shfl_xor(t, 16); t += __shfl_xor(t, 32); o[gq][j] = t; }
        if (ksub == 0) { u32x2 w; w.x = pk2(o[gq][0], o[gq][1]); w.y = pk2(o[gq][2], o[gq][3]); *(u32x2*)(mix + m * DM + 1024 + (kvh * 4 + gq) * 64 + dq) = w; } }
    LDS_WAIT(); asm volatile("" ::: "memory");
}
__device__ __forceinline__ void p4_mixers(const Args& a, LAS unsigned char* lds, int G) {
    const int tid = threadIdx.x, lane = tid & 63, wave = __builtin_amdgcn_readfirstlane(tid >> 6);
    for (int rep = 0; rep < ((MK_DUP & 4) ? 2 : 1); ++rep) {
    for (int it = blockIdx.x; it < 256; it += G) scan_prompt_item(a, lds, it);
    for (int it = blockIdx.x * 8 + wave; it < NSAMP * 16; it += G * 8) scan_sample_pair(a, lds, it);
    __syncthreads(); }
    for (int rep = 0; rep < ((MK_DUP & 8) ? 2 : 1); ++rep) {
    if (wave >= 4) __builtin_amdgcn_s_setprio(1);
    for (int u = blockIdx.x; u < 512; u += 2 * G) { const int u1 = u + G < 512 ? u + G : -1;
        attn_stage2(a, lds, u, u1); const AttnQ q0 = attn_load_q(a, u);
        __syncthreads();
        attn_compute(a, lds, u, q0);
        if (u1 >= 0) { const AttnQ q1 = attn_load_q(a, u1); attn_compute(a, lds + AT_BUF, u1, q1); }
        __syncthreads(); }
    __builtin_amdgcn_s_setprio(0);
    for (int u = blockIdx.x + G * wave; u < 512; u += G * 8) attn_sample_unit(a, (LAS float*)lds + wave * 512, u, lane);
    __syncthreads(); }
    const bf16_t* z = (const bf16_t*)(a.ws + WS_Z); const int gt = blockIdx.x * 512 + tid, NGT = G * 512;
    for (int i = gt; i < 8 * RWKV_PROJ; i += NGT) { const int b = i / RWKV_PROJ, c = i % RWKV_PROJ; a.out[O_SHP + i] = bf2f(z[((size_t)b * SEQ + SEQ - 1) * ZP + c]); }
    for (int i = gt; i < NSAMP * RWKV_PROJ; i += NGT) { const int b = i / RWKV_PROJ, c = i % RWKV_PROJ; a.out[O_SHS + i] = bf2f(z[((size_t)MPROMPT + b) * ZP + c]); }
    for (int i = gt; i < 8 * 128 * 256; i += NGT) { const int c = i & 255, s = (i >> 8) & 127, b = i >> 15; const bf16_t* zr = z + ((size_t)b * SEQ + SEQ - 128 + s) * ZP;
        a.out[O_KP + i] = bf2f(zr[ZK + c]); a.out[O_VP + i] = bf2f(zr[ZV + c]); }
}

struct P5Raw { u32x2 y, zv, gl; float bon; };
__device__ __forceinline__ P5Raw p5_load(const bf16_t* z, const bf16_t* lo, const bf16_t* ybuf, const float* bonp, size_t m, int j) {
    P5Raw r; r.y = __builtin_nontemporal_load((const u32x2*)(ybuf + m * 1024 + j)); r.zv = __builtin_nontemporal_load((const u32x2*)(z + m * ZP + j + 2048)); r.gl = __builtin_nontemporal_load((const u32x2*)(lo + m * 3072 + j + 2048)); r.bon = bonp[m * 16 + (j >> 6)]; return r;
}
struct P5Const { f32x4 mu_v, lw, lb; };
__device__ __forceinline__ void p5_compute(const P5Raw& c, f32x4 pv, const P5Const& k_, bf16_t* dst) {
    const f32x4 zv = bf4(c.zv), gg = bf4(c.gl);
    const f32x4 v = zv + (pv - zv) * k_.mu_v;
    const f32x4 y = bf4(c.y);
    const float mean = row16_sum((y[0] + y[1]) + (y[2] + y[3])) * (1.f / 64.f); const f32x4 dy = y - mean;
    const float var = row16_sum((dy[0] * dy[0] + dy[1] * dy[1]) + (dy[2] * dy[2] + dy[3] * dy[3])) * (1.f / 64.f); const float rstd = rsqrtf(var + GN_EPS);
    const f32x4 o = (dy * rstd * k_.lw + k_.lb + c.bon * v) * gg;
    u32x2 w; w.x = pk2(o[0], o[1]); w.y = pk2(o[2], o[3]); *(u32x2*)dst = w;
}
__device__ __forceinline__ void p5_rwkv_post(const Args& a, int G) {
    const int tid = threadIdx.x, lane = tid & 63, wave = tid >> 6, gw = blockIdx.x * 8 + wave, NGW = G * 8;
    const bf16_t* z = (const bf16_t*)(a.ws + WS_Z); const bf16_t* lo = (const bf16_t*)(a.ws + WS_LORA); bf16_t* mix = (bf16_t*)(a.ws + WS_MIX);
    const bf16_t* ybuf = (const bf16_t*)(a.ws + WS_HB); const float* bonp = (const float*)(a.ws + WS_BON);
    for (int ck = gw; ck < MPROMPT / 8; ck += NGW) { const size_t m0 = (size_t)(ck >> 2) * 32; const int j = ((ck & 3) * 4 + (lane >> 4)) * 64 + (lane & 15) * 4;
        const P5Const kc{*(const f32x4*)(a.in[I_MU] + 2048 + j), *(const f32x4*)(a.in[I_LNW] + j), *(const f32x4*)(a.in[I_LNB] + j)};
        f32x4 pv = {0.f, 0.f, 0.f, 0.f}; P5Raw ring[4];
#pragma unroll
        for (int i = 0; i < 4; ++i) ring[i] = p5_load(z, lo, ybuf, bonp, m0 + i, j);
        if ((m0 % SEQ) != 0) pv = bf4(*(const u32x2*)(z + (m0 - 1) * ZP + j + 2048));
#pragma unroll 1
        for (int t = 0; t < 32; t += 4) {
#pragma unroll
            for (int i = 0; i < 4; ++i) { const size_t m = m0 + t + i; const P5Raw c = ring[i];
                p5_compute(c, pv, kc, mix + m * DM + j);
                pv = bf4(c.zv);
                if (t + 4 < 32) ring[i] = p5_load(z, lo, ybuf, bonp, m + 4, j); } }
    }
    for (int q = gw; q < NSAMP * 4; q += NGW) { const size_t m = (size_t)MPROMPT + (q >> 2); const int hg = q & 3, j = (hg * 4 + (lane >> 4)) * 64 + (lane & 15) * 4;
        const float* sh = a.in[I_SSHIFT] + (m - MPROMPT) * RWKV_PROJ + j; const P5Raw c = p5_load(z, lo, ybuf, bonp, m, j);
        const P5Const kc{*(const f32x4*)(a.in[I_MU] + 2048 + j), *(const f32x4*)(a.in[I_LNW] + j), *(const f32x4*)(a.in[I_LNB] + j)};
        p5_compute(c, *(const f32x4*)(sh + 2048), kc, mix + m * DM + j); }
}

__device__ __forceinline__ void p7_convert_p(const Args& a, int wg, int nwgs) {
    bf16_t* pb = (bf16_t*)(a.ws + WS_PB); const int gt = wg * 512 + threadIdx.x, NGT = nwgs * 512;
    for (int i = gt; i < MP * PLE / 4; i += NGT) { const int m = i / (PLE / 4), c4 = i % (PLE / 4); f32x4 v = {0.f, 0.f, 0.f, 0.f};
        if (m < MPROMPT) v = ((const f32x4*)a.in[I_PP])[(size_t)m * (PLE / 4) + c4]; else if (m < MTOK) v = ((const f32x4*)a.in[I_PS])[(size_t)(m - MPROMPT) * (PLE / 4) + c4];
        u32x2 w; w.x = pk2(v[0], v[1]); w.y = pk2(v[2], v[3]); ((u32x2*)pb)[i] = w; }
}
__device__ __forceinline__ void p10_final_norm(const Args& a, int G) {
    const int tid = threadIdx.x, lane = tid & 63, wave = tid >> 6, gw = blockIdx.x * 8 + wave, NGW = G * 8; const float* ss3 = (const float*)(a.ws + WS_SS3);
    const bf16_t* x3b = (const bf16_t*)(a.ws + WS_X3);
    for (int m = gw; m < MTOK; m += NGW) { const float rs = rsqrtf(ss3[m] * (1.f / DM) + EPS); f32x4* yr = (f32x4*)(a.out + (size_t)m * DM); const u32x4* xr = (const u32x4*)(x3b + (size_t)m * DM);
#pragma unroll
        for (int j = 0; j < 4; ++j) { const u32x4 w = __builtin_nontemporal_load(xr + lane + 64 * j); const f32x4 g0 = ((const f32x4*)a.in[I_FNORM])[2 * (lane + 64 * j)], g1 = ((const f32x4*)a.in[I_FNORM])[2 * (lane + 64 * j) + 1];
            __builtin_nontemporal_store((f32x4){bflo(w.x), bfhi(w.x), bflo(w.y), bfhi(w.y)} * rs * g0, yr + 2 * (lane + 64 * j)); __builtin_nontemporal_store((f32x4){bflo(w.z), bfhi(w.z), bflo(w.w), bfhi(w.w)} * rs * g1, yr + 2 * (lane + 64 * j) + 1); } }
}

typedef GAS unsigned gu32;
#define XB_TMO      128
#define XB_XCNT(j)  (256  + 64 * (j))
#define XB_XSUB(j)  (1280 + 64 * (j))
#define XB_XGEN(j)  (2304 + 64 * (j))
#define XB_TOP      3328
#define XB_TOPGEN   3392
#define XCD_BAR_WORDS 3456
#define XB_SPIN_CAP (1u << 18)
__device__ __forceinline__ unsigned xb_ld(unsigned* p)              { return __hip_atomic_load(p, __ATOMIC_RELAXED, __HIP_MEMORY_SCOPE_AGENT); }
__device__ __forceinline__ unsigned xb_add(unsigned* p, unsigned v) { return __hip_atomic_fetch_add(p, v, __ATOMIC_RELAXED, __HIP_MEMORY_SCOPE_AGENT); }
__device__ __forceinline__ unsigned xb_xcc_id() { return (unsigned)__builtin_amdgcn_s_getreg((3 << 11) | 20) & 0xFu; }
#define XB_SPIN(cond, bar) do { unsigned _sp = 0; while (cond) { __builtin_amdgcn_s_sleep(1); \
    if ((++_sp & 255u) == 0u) { if (xb_ld(&(bar)[XB_TMO])) break; if (_sp > XB_SPIN_CAP) { atomicAdd(&(bar)[XB_TMO], 1u); break; } } } } while (0)
struct XcdBarrier { unsigned* bar; unsigned x; volatile LAS unsigned* st; };
__device__ __forceinline__ XcdBarrier xcd_barrier_post(unsigned* bar, volatile LAS unsigned* st) {
    XcdBarrier b; b.bar = bar; b.x = xb_xcc_id(); b.st = st;
    if (threadIdx.x == 0) (void)xb_add(&bar[XB_XCNT(b.x)], 1u);
    return b;
}
__device__ __forceinline__ void xcd_barrier_complete(unsigned* bar, unsigned x, unsigned& nloc, unsigned& nx) {
    const unsigned G = gridDim.x * gridDim.y * gridDim.z;
    unsigned sum, cnt, mine, sp = 0u;
    for (;;) {
        sum = 0u; cnt = 0u; mine = 0u;
#pragma unroll
        for (unsigned j = 0; j < 16; ++j) { const unsigned c = xb_ld(&bar[XB_XCNT(j)]); sum += c; cnt += (c > 0u) ? 1u : 0u; mine = (j == x) ? c : mine; }
        if (sum == G) break;
        __builtin_amdgcn_s_sleep(1);
        if ((++sp & 255u) == 0u) { if (xb_ld(&bar[XB_TMO])) break; if (sp > XB_SPIN_CAP) { atomicAdd(&bar[XB_TMO], 1u); break; } }
    }
    nloc = mine > 0u ? mine : 1u; nx = cnt > 0u ? cnt : 1u;
}
__device__ __forceinline__ void xcd_barrier(const XcdBarrier& b) {
    asm volatile("s_waitcnt vmcnt(0)" ::: "memory");
    __syncthreads();
    if (threadIdx.x == 0) {
        unsigned* bar = b.bar;
        __builtin_amdgcn_s_waitcnt(0);
        unsigned nloc = b.st[0], nx = b.st[1];
        if (nloc == 0u) { xcd_barrier_complete(bar, b.x, nloc, nx); b.st[0] = nloc; b.st[1] = nx; }
        const unsigned old = xb_add(&bar[XB_XSUB(b.x)], 1u);
        const unsigned gen = old / nloc;
        if (old + 1u == (gen + 1u) * nloc) {
            __builtin_amdgcn_fence(__ATOMIC_RELEASE, "agent");
            asm volatile("s_waitcnt vmcnt(0)" ::: "memory");
            const unsigned og = xb_add(&bar[XB_TOP], 1u);
            const unsigned tg = og / nx;
            if (og + 1u == (tg + 1u) * nx) xb_add(&bar[XB_TOPGEN], 1u);
            else XB_SPIN(xb_ld(&bar[XB_TOPGEN]) == tg, bar);
            __builtin_amdgcn_fence(__ATOMIC_ACQUIRE, "agent");
            xb_add(&bar[XB_XGEN(b.x)], 1u);
            asm volatile("s_waitcnt vmcnt(0)" ::: "memory");
        } else {
            XB_SPIN(xb_ld(&bar[XB_XGEN(b.x)]) == gen, bar);
            __builtin_amdgcn_fence(__ATOMIC_ACQUIRE, "agent");
            asm volatile("s_waitcnt vmcnt(0)" ::: "memory");
        }
    }
    __syncthreads();
}
constexpr int CW_BAR = 4096;
constexpr size_t CTL_ZERO_BYTES = 65536;
constexpr int LDSCTL_OFF = LDS_BYTES - 256;

__global__ void __launch_bounds__(512, 2) mk_fwd(Args a) {
    extern __shared__ __attribute__((aligned(16))) unsigned char lds_raw[];
    LAS unsigned char* lds = (LAS unsigned char*)lds_raw;
    const int G = gridDim.x; unsigned char* ws = a.ws;
    const int lo = a.ph_lo, hi = a.ph_hi;
    for (int u = threadIdx.x; u < 64; u += 512) ((LAS unsigned*)(lds + LDSCTL_OFF))[u] = 0u;
    __syncthreads();
    XcdBarrier bar; bar.bar = (unsigned*)(ws + WS_CTL) + CW_BAR; bar.x = 0; bar.st = nullptr;
    if (hi - lo > 1) bar = xcd_barrier_post((unsigned*)(ws + WS_CTL) + CW_BAR, (volatile LAS unsigned*)(lds + LDSCTL_OFF) + 8);
#define IN(k) (lo <= (k) && (k) < hi)
#define SEAM(k) do { if (IN(k) && IN((k) + 1)) { xcd_barrier(bar); } } while (0)
    if (IN(0)) { if (MK_DUP & 1) { p0_prologue(a, lds, G); __syncthreads(); } p0_prologue(a, lds, G); }
    SEAM(0);
    if (IN(1)) { pg8::Gemm g{(const bf16_t*)(ws + WS_HB), (const bf16_t*)(ws + WS_WIN), MP, ZP, DM, DM, DM, 1 << 30, 0}; pg8::StaticOrder S; S.init(MPROMPT, ZP, G, (int)blockIdx.x, -1, 2 * (ZP / 256), 64);
        pg8::EpiBf16 E{(bf16_t*)(ws + WS_Z), ZP}; pg8::gemm_phase<pg8::EpiBf16>(lds, g, S, E); tail_convert(a, lds, 64 * (ZP / 256) + 2 * (ZP / 256), G, 1, 4); tail_convert(a, lds, 64 * (ZP / 256) + 2 * (ZP / 256), G, 5, 7);
        { const int rem = (64 * (ZP / 256) + 2 * (ZP / 256)) % G, c = (int)blockIdx.x; if (rem == 0) p7_convert_p(a, c, G); else if (c >= rem) p7_convert_p(a, c - rem, G - rem); } }
    SEAM(1);
    if (IN(2)) { if (MK_DUP & 32) p2_lora_fused(a, lds, G); p2_lora_fused(a, lds, G); }
    SEAM(2);
    if (IN(4)) { p4_mixers(a, lds, G); }
    SEAM(4);
    if (IN(5)) { if (MK_DUP & 16) p5_rwkv_post(a, G); p5_rwkv_post(a, G); }
    SEAM(5);
    if (IN(6)) { pg8::Gemm g{(const bf16_t*)(ws + WS_MIX), (const bf16_t*)(ws + WS_WOUT), MP, DM, DM, DM, DM, 1 << 30, 0}; pg8::StaticOrder S; S.init(MPROMPT, DM, G, (int)blockIdx.x, -1, 16, 64);
        pg8::EpiResid E{a.in[I_XP], a.in[I_XS], (bf16_t*)(ws + WS_HB), (float*)(ws + WS_SS1)}; pg8::gemm_phase<pg8::EpiResid>(lds, g, S, E);
        { const int nwg = 64 * (DM / 256) + 16, rem = nwg % G; const int c2 = rem ? (int)blockIdx.x - rem : (int)blockIdx.x, G2 = rem ? G - rem : G;
          if (c2 >= 0) { pg8::Gemm g2{(const bf16_t*)(ws + WS_PB), (const bf16_t*)(ws + WS_WPP), MP, DM, PLE, PLE, PLE, 1 << 30, 0}; pg8::StaticOrder S2; S2.init(MP, DM, G2, c2, 64);
              pg8::EpiBf16 E2{(bf16_t*)(ws + WS_X3), DM}; pg8::gemm_phase<pg8::EpiBf16>(lds, g2, S2, E2); } } }
    SEAM(6);
    if (IN(7)) {
        pg8::Gemm g{(const bf16_t*)(ws + WS_HB), (const bf16_t*)(ws + WS_WGU), MP, 2 * DFF, DM, DM, DM, 1 << 30, 0}; pg8::StaticOrder S; S.init(MPROMPT, 2 * DFF, G, (int)blockIdx.x, -1, 2 * (2 * DFF / 256), 64);
        pg8::EpiGateUp E{(bf16_t*)(ws + WS_HID), (const float*)(ws + WS_SS1)}; pg8::gemm_phase<pg8::EpiGateUp>(lds, g, S, E); tail_convert(a, lds, 64 * 44 + 88, G, 4, 5); }
    SEAM(7);
    if (IN(8)) { pg8::Gemm g{(const bf16_t*)(ws + WS_HID), (const bf16_t*)(ws + WS_WD), MP, DM, DFF, DFF, DFF, 1 << 30, 0}; pg8::StaticOrder S; S.init(MPROMPT, DM, G, (int)blockIdx.x, -1, 0, 64);
        pg8::EpiResid E{nullptr, nullptr, (bf16_t*)(ws + WS_HB), (float*)(ws + WS_SS2)}; pg8::gemm_phase<pg8::EpiResid>(lds, g, S, E);
        skinny_phase<SK_RESID_INPLACE, 2, 1, 4>(lds, SkArgs{(const bf16_t*)(ws + WS_HID) + (size_t)MPROMPT * DFF, DFF, (const bf16_t*)(ws + WS_WD), DFF, DFF, DM, (bf16_t*)(ws + WS_HB), DM, nullptr, (float*)(ws + WS_SS2), nullptr, nullptr, nullptr}, G); }
    SEAM(8);
    if (IN(9)) { pg8::StaticOrder S; S.init(MPROMPT, DM, G, (int)blockIdx.x, -1, 0, 64);
        pg8::Gemm g{(const bf16_t*)(ws + WS_HB), (const bf16_t*)(ws + WS_WPG), MP, DM, DM, DM, DM, 1 << 30, 0};
        pg8::EpiPle E{(const bf16_t*)(ws + WS_HB), (bf16_t*)(ws + WS_X3), (const bf16_t*)(ws + WS_X3), (const float*)(ws + WS_SS2), (float*)(ws + WS_SS3)}; pg8::gemm_phase<pg8::EpiPle>(lds, g, S, E);
        skinny_phase<SK_PLE, 2, 1, 4>(lds, SkArgs{(const bf16_t*)(ws + WS_HB) + (size_t)MPROMPT * DM, DM, (const bf16_t*)(ws + WS_WPG), DM, DM, DM, (bf16_t*)(ws + WS_X3), DM, nullptr, (float*)(ws + WS_SS3), (const float*)(ws + WS_SS2),
            (const bf16_t*)(ws + WS_HB), (const bf16_t*)(ws + WS_X3)}, G); }
    SEAM(9);
    if (IN(10)) { p10_final_norm(a, G); }
#undef IN
#undef SEAM
}

extern "C" void kernel_launch(void* const* d_in, const int* in_sizes, int n_in, void* d_out, int out_size, void* d_ws, size_t ws_size, hipStream_t stream) {
    static int grid = 0;
    if (grid == 0) {
        if (n_in != 31 || ws_size < WS_END) { fprintf(stderr, "kernel_launch: expected 31 inputs and >= %zu bytes of workspace, got %d / %zu\n", (size_t)WS_END, n_in, ws_size); grid = -1; return; }
        int dev = 0, cus = 0;
        if (hipGetDevice(&dev) != hipSuccess || hipDeviceGetAttribute(&cus, hipDeviceAttributeMultiprocessorCount, dev) != hipSuccess) { grid = -1; return; }
        if (hipFuncSetAttribute((const void*)mk_fwd, hipFuncAttributeMaxDynamicSharedMemorySize, LDS_BYTES) != hipSuccess) { fprintf(stderr, "kernel_launch: hipFuncSetAttribute failed\n"); grid = -1; return; }
        grid = cus;
    }
    if (grid < 0) return;
    Args a{};
    for (int i = 0; i < 31; ++i) a.in[i] = (const float*)d_in[i];
    a.out = (float*)d_out; a.ws = (unsigned char*)d_ws;
#if MK_ONE_LAUNCH
    if (hipMemsetAsync((char*)d_ws + WS_CTL, 0, CTL_ZERO_BYTES, stream) != hipSuccess) { fprintf(stderr, "kernel_launch: hipMemsetAsync failed\n"); return; }
    a.ph_lo = 0; a.ph_hi = NPHASE; hipLaunchKernelGGL(mk_fwd, dim3(grid), dim3(512), LDS_BYTES, stream, a);
#else
    for (int p = 0; p < NPHASE; ++p) { a.ph_lo = p; a.ph_hi = p + 1; hipLaunchKernelGGL(mk_fwd, dim3(grid), dim3(512), LDS_BYTES, stream, a); }
#endif
}
```
